# Optimizing an MI355X kernel written in HIP

```python
import jax, jax.numpy as jnp
from jax import lax
import numpy as np

D_MODEL = 1024
BATCH = 2
SEQ = 8192
DEPTH = 4
DEC_BATCH = 128
DEC_SEQ = 1
PAST_LEN = 2048
PAGE_SIZE = 128

N_LAYERS_A = DEPTH // 2
N_LAYERS_B = DEPTH - N_LAYERS_A
HEADS_A = 8
DK_A = 128
DV_A = 128
KEY_W_A = HEADS_A * DK_A
VAL_W_A = HEADS_A * DV_A
QKV_W_A = 2 * KEY_W_A + VAL_W_A
PROJ_W_A = QKV_W_A + VAL_W_A + 2 * HEADS_A
CONV_W = 4
GDN_CHUNK = 64
BRANCH_WINDOWS = (128, 512, 2048)
BRANCH_DILATIONS = (1, 4, 16)
N_BRANCH = 3
HEADS_B = 8
KV_HEADS_B = 2
GQA_B = HEADS_B // KV_HEADS_B
HEAD_DIM_B = 64
Q_W_B = N_BRANCH * HEADS_B * HEAD_DIM_B
KV_W_B = N_BRANCH * 2 * KV_HEADS_B * HEAD_DIM_B
OUT_W_B = HEADS_B * HEAD_DIM_B
Q_BLOCK = 128
D_FF = 4 * D_MODEL
EPS = 1e-6

kernel_name = 'yoco_gdn_dilated_alibi_decoder_step'


def rmsnorm(x, gain):
    xf = x.astype(jnp.float32)
    y = xf * lax.rsqrt(jnp.mean(xf * xf, axis=-1, keepdims=True) + EPS)
    return (y * gain.astype(jnp.float32)).astype(x.dtype)


def l2norm(x):
    return x * lax.rsqrt(jnp.sum(x * x, axis=-1, keepdims=True) + EPS)


def sq_relu_mlp(h, w_up, w_down):
    u = jax.nn.relu(h @ w_up)
    return (u * u) @ w_down


def alibi_slopes():
    return jnp.exp2(-8.0 * jnp.arange(1, HEADS_B + 1, dtype=jnp.float32) / HEADS_B)


def gated_delta_rule(q, k, v, g, beta, s0):
    N, L, H, _ = q.shape
    C = GDN_CHUNK
    n_chunks = -(-L // C)
    pad = n_chunks * C - L

    def to_chunks(t):
        t = jnp.pad(t.astype(jnp.float32), [(0, 0), (0, pad)] + [(0, 0)] * (t.ndim - 2))
        t = t.reshape((N, n_chunks, C) + t.shape[2:])
        return t.transpose((1, 0, 3, 2) + tuple(range(4, t.ndim)))

    qc, kc, vc, gc, bc = (to_chunks(t) for t in (q, k, v, g, beta))
    G = jnp.cumsum(gc, axis=-1)
    causal = jnp.tril(jnp.ones((C, C), dtype=bool))
    strict = jnp.tril(jnp.ones((C, C), dtype=bool), -1)
    diff = G[..., :, None] - G[..., None, :]
    decay = jnp.where(causal, jnp.exp(jnp.where(causal, diff, 0.0)), 0.0)
    kb = kc * bc[..., None]
    lower = jnp.where(strict, jnp.einsum('...ik,...jk->...ij', kb, kc) * decay, 0.0)
    eye = jnp.broadcast_to(jnp.eye(C, dtype=jnp.float32), lower.shape)
    T = lax.linalg.triangular_solve(eye + lower, eye, left_side=True, lower=True, unit_diagonal=True)
    u = jnp.einsum('...ij,...jv->...iv', T, vc * bc[..., None])
    w = jnp.einsum('...ij,...jk->...ik', T, kb * jnp.exp(G)[..., None])
    attn = jnp.einsum('...ik,...jk->...ij', qc, kc) * decay
    q_dec = qc * jnp.exp(G)[..., None]
    G_last = G[..., -1]
    k_dec = kc * jnp.exp(G_last[..., None] - G)[..., None]
    decay_last = jnp.exp(G_last)

    def step(S, inp):
        u_c, w_c, qd_c, kd_c, a_c, dl_c = inp
        v_new = u_c - jnp.einsum('nhck,nhkv->nhcv', w_c, S)
        o_c = jnp.einsum('nhck,nhkv->nhcv', qd_c, S) + jnp.einsum('nhcj,nhjv->nhcv', a_c, v_new)
        S = S * dl_c[..., None, None] + jnp.einsum('nhck,nhcv->nhkv', kd_c, v_new)
        return S, o_c

    S_fin, o = lax.scan(step, s0.astype(jnp.float32), (u, w, q_dec, k_dec, attn, decay_last))
    o = o.transpose(1, 0, 3, 2, 4).reshape(N, n_chunks * C, H, DV_A)[:, :L]
    return o, S_fin


def gdn_mixer(h, s0, conv_buf, w_in, w_conv, a_log, dt_bias, g_norm, w_out):
    N, L, _ = h.shape
    proj = h @ w_in
    qkv = proj[..., :QKV_W_A]
    z = proj[..., QKV_W_A:QKV_W_A + VAL_W_A]
    b_raw = proj[..., QKV_W_A + VAL_W_A:QKV_W_A + VAL_W_A + HEADS_A]
    a_raw = proj[..., QKV_W_A + VAL_W_A + HEADS_A:]
    ext = jnp.concatenate([conv_buf.astype(qkv.dtype), qkv], axis=1)
    new_conv = ext[:, ext.shape[1] - (CONV_W - 1):]
    conv = sum(ext[:, j:j + L] * w_conv[j] for j in range(CONV_W))
    qkv_c = jax.nn.silu(conv.astype(jnp.float32))
    q = l2norm(qkv_c[..., :KEY_W_A].reshape(N, L, HEADS_A, DK_A)) * (DK_A ** -0.5)
    k = l2norm(qkv_c[..., KEY_W_A:2 * KEY_W_A].reshape(N, L, HEADS_A, DK_A))
    v = qkv_c[..., 2 * KEY_W_A:].reshape(N, L, HEADS_A, DV_A)
    beta = jax.nn.sigmoid(b_raw.astype(jnp.float32))
    g = -jnp.exp(a_log.astype(jnp.float32)) * jax.nn.softplus(a_raw.astype(jnp.float32) + dt_bias.astype(jnp.float32))
    o, s_new = gated_delta_rule(q, k, v, g, beta, s0)
    o = o * lax.rsqrt(jnp.mean(o * o, axis=-1, keepdims=True) + EPS) * g_norm.astype(jnp.float32)
    o = o * jax.nn.silu(z.astype(jnp.float32).reshape(N, L, HEADS_A, DV_A))
    out = o.reshape(N, L, VAL_W_A).astype(h.dtype) @ w_out
    return out, s_new.astype(s0.dtype), new_conv.astype(conv_buf.dtype)


def dilated_branch(q, k_ext, v_ext, q_start, window, dilation, slopes):
    N, Lq = q.shape[0], q.shape[1]
    qb = Q_BLOCK if Lq % Q_BLOCK == 0 else Lq
    nb = Lq // qb
    dist = jnp.arange(window // dilation + 1, dtype=jnp.int32) * dilation
    bias = -slopes[:, :, None] * dist.astype(jnp.float32)
    scale = HEAD_DIM_B ** -0.5

    def block(args):
        q_blk, start = args
        kidx = (start + jnp.arange(qb, dtype=jnp.int32))[:, None] - dist[None, :]
        valid = kidx >= 0
        kidx = jnp.maximum(kidx, 0)
        kg = jnp.take(k_ext, kidx, axis=1).astype(jnp.float32)
        vg = jnp.take(v_ext, kidx, axis=1).astype(jnp.float32)
        s = jnp.einsum('nqhgd,nqkhd->nqhgk', q_blk.astype(jnp.float32), kg) * scale + bias
        s = jnp.where(valid[None, :, None, None, :], s, -jnp.inf)
        m = jnp.max(s, axis=-1, keepdims=True)
        lse = m + jnp.log(jnp.sum(jnp.exp(s - m), axis=-1, keepdims=True))
        p = jnp.exp(s - lse)
        o = jnp.einsum('nqhgk,nqkhd->nqhgd', p, vg)
        return o, lse[..., 0]

    q_blocks = q.reshape((N, nb, qb) + q.shape[2:]).swapaxes(0, 1)
    starts = q_start + jnp.arange(nb, dtype=jnp.int32) * qb
    o, lse = lax.map(block, (q_blocks, starts))
    o = o.swapaxes(0, 1).reshape((N, Lq) + o.shape[3:])
    lse = lse.swapaxes(0, 1).reshape((N, Lq) + lse.shape[3:])
    return o, lse


def dilated_mixer(h, kv_exts, buf_lens, w_q, w_o):
    N, L, _ = h.shape
    q = (h @ w_q).reshape(N, L, N_BRANCH, KV_HEADS_B, GQA_B, HEAD_DIM_B)
    slopes = alibi_slopes().reshape(KV_HEADS_B, GQA_B)
    outs, lses = [], []
    for bi in range(N_BRANCH):
        o, lse = dilated_branch(q[:, :, bi], kv_exts[bi][:, :, 0], kv_exts[bi][:, :, 1], buf_lens[bi],
                                BRANCH_WINDOWS[bi], BRANCH_DILATIONS[bi], slopes)
        outs.append(o)
        lses.append(lse)
    wts = jax.nn.softmax(jnp.stack(lses), axis=0)
    out = jnp.sum(wts[..., None] * jnp.stack(outs), axis=0)
    return out.reshape(N, L, OUT_W_B).astype(h.dtype) @ w_o


def trunk(x, rec0, conv0, kv_bufs, w):
    N, L, _ = x.shape
    rec_new, conv_new, bufs_new, kv_exts = [], [], [], []
    buf_lens = [b.shape[1] for b in kv_bufs]
    for l in range(DEPTH):
        if l < N_LAYERS_A:
            mix, s_l, c_l = gdn_mixer(rmsnorm(x, w['norm_mix'][l]), rec0[l], conv0[l], w['w_in_a'][l],
                                      w['conv_a'][l], w['a_log'][l], w['dt_bias'][l], w['norm_o_a'][l],
                                      w['w_out_a'][l])
            rec_new.append(s_l)
            conv_new.append(c_l)
        else:
            if l == N_LAYERS_A:
                kv = (rmsnorm(x, w['norm_kv']) @ w['w_kv']).reshape(N, L, N_BRANCH, 2, KV_HEADS_B, HEAD_DIM_B)
                for bi in range(N_BRANCH):
                    e = jnp.concatenate([kv_bufs[bi].astype(kv.dtype), kv[:, :, bi]], axis=1)
                    kv_exts.append(e)
                    keep = min(BRANCH_WINDOWS[bi], e.shape[1])
                    bufs_new.append(e[:, e.shape[1] - keep:].astype(kv_bufs[bi].dtype))
            mix = dilated_mixer(rmsnorm(x, w['norm_mix'][l]), kv_exts, buf_lens,
                                w['w_q_b'][l - N_LAYERS_A], w['w_o_b'][l - N_LAYERS_A])
        x = x + mix
        x = x + sq_relu_mlp(rmsnorm(x, w['norm_mlp'][l]), w['w_up'][l], w['w_down'][l])
    y = rmsnorm(x, w['norm_final'])
    return y, jnp.stack(rec_new), jnp.stack(conv_new), bufs_new[0], bufs_new[1], bufs_new[2]


def setup_inputs(seed: int = 0) -> dict:
    key = jax.random.key(seed)
    ks = jax.random.split(key, 24)
    f32 = jnp.float32
    nrm = lambda k, shape, s: jax.random.normal(k, shape, f32) * s
    gain = lambda k, shape: 1.0 + 0.02 * jax.random.normal(k, shape, f32)
    dt = jnp.exp(jax.random.uniform(ks[5], (N_LAYERS_A, HEADS_A), f32, np.log(1e-3), np.log(1e-1)))
    return {
        'x_prompt': nrm(ks[0], (BATCH, SEQ, D_MODEL), 1.0),
        'x_sample': nrm(ks[1], (DEC_BATCH, DEC_SEQ, D_MODEL), 1.0),
        'state_a_rec': nrm(ks[2], (N_LAYERS_A, DEC_BATCH, HEADS_A, DK_A, DV_A), 0.1),
        'state_a_conv': nrm(ks[3], (N_LAYERS_A, DEC_BATCH, CONV_W - 1, QKV_W_A), 1.0),
        'cache_b0_kv': nrm(ks[4], (DEC_BATCH, min(BRANCH_WINDOWS[0], PAST_LEN), 2, KV_HEADS_B, HEAD_DIM_B), 1.0),
        'cache_b1_kv': nrm(ks[6], (DEC_BATCH, min(BRANCH_WINDOWS[1], PAST_LEN), 2, KV_HEADS_B, HEAD_DIM_B), 1.0),
        'cache_b2_kv': nrm(ks[7], (DEC_BATCH, min(BRANCH_WINDOWS[2], PAST_LEN), 2, KV_HEADS_B, HEAD_DIM_B), 1.0),
        'norm_mix': gain(ks[8], (DEPTH, D_MODEL)),
        'norm_mlp': gain(ks[9], (DEPTH, D_MODEL)),
        'w_in_a': nrm(ks[10], (N_LAYERS_A, D_MODEL, PROJ_W_A), D_MODEL ** -0.5),
        'conv_a': nrm(ks[11], (N_LAYERS_A, CONV_W, QKV_W_A), CONV_W ** -0.5),
        'a_log': jnp.log(jax.random.uniform(ks[12], (N_LAYERS_A, HEADS_A), f32, 1.0, 16.0)),
        'dt_bias': dt + jnp.log(-jnp.expm1(-dt)),
        'norm_o_a': gain(ks[13], (N_LAYERS_A, DV_A)),
        'w_out_a': nrm(ks[14], (N_LAYERS_A, VAL_W_A, D_MODEL), VAL_W_A ** -0.5),
        'norm_kv': gain(ks[15], (D_MODEL,)),
        'w_kv': nrm(ks[16], (D_MODEL, KV_W_B), D_MODEL ** -0.5),
        'w_q_b': nrm(ks[17], (N_LAYERS_B, D_MODEL, Q_W_B), D_MODEL ** -0.5),
        'w_o_b': nrm(ks[18], (N_LAYERS_B, OUT_W_B, D_MODEL), OUT_W_B ** -0.5),
        'w_up': nrm(ks[19], (DEPTH, D_MODEL, D_FF), D_MODEL ** -0.5),
        'w_down': nrm(ks[20], (DEPTH, D_FF, D_MODEL), D_FF ** -0.5),
        'norm_final': gain(ks[21], (D_MODEL,)),
    }


def reference(x_prompt, x_sample, state_a_rec, state_a_conv, cache_b0_kv, cache_b1_kv, cache_b2_kv,
              norm_mix, norm_mlp, w_in_a, conv_a, a_log, dt_bias, norm_o_a, w_out_a, norm_kv, w_kv,
              w_q_b, w_o_b, w_up, w_down, norm_final):
    w = {'norm_mix': norm_mix, 'norm_mlp': norm_mlp, 'w_in_a': w_in_a, 'conv_a': conv_a, 'a_log': a_log,
         'dt_bias': dt_bias, 'norm_o_a': norm_o_a, 'w_out_a': w_out_a, 'norm_kv': norm_kv, 'w_kv': w_kv,
         'w_q_b': w_q_b, 'w_o_b': w_o_b, 'w_up': w_up, 'w_down': w_down, 'norm_final': norm_final}
    p_rec0 = jnp.zeros((N_LAYERS_A, BATCH, HEADS_A, DK_A, DV_A), state_a_rec.dtype)
    p_conv0 = jnp.zeros((N_LAYERS_A, BATCH, CONV_W - 1, QKV_W_A), state_a_conv.dtype)
    p_bufs0 = [jnp.zeros((BATCH, 0, 2, KV_HEADS_B, HEAD_DIM_B), c.dtype) for c in (cache_b0_kv, cache_b1_kv, cache_b2_kv)]
    y_prompt, p_rec, p_conv, p_kv0, p_kv1, p_kv2 = trunk(x_prompt, p_rec0, p_conv0, p_bufs0, w)
    y_sample, s_rec, s_conv, s_kv0, s_kv1, s_kv2 = trunk(
        x_sample, state_a_rec, state_a_conv, [cache_b0_kv, cache_b1_kv, cache_b2_kv], w)
    return (y_prompt, y_sample, p_rec, p_conv, p_kv0, p_kv1, p_kv2, s_rec, s_conv, s_kv0, s_kv1, s_kv2)
```

```cpp
#include <hip/hip_runtime.h>
#include <hip/hip_cooperative_groups.h>
#include <cstdio>
#include <cstdint>
namespace cg = cooperative_groups;
__device__ __forceinline__ int lnd_v(int x) { asm volatile("" : "+v"(x)); return x; }
__device__ __forceinline__ int lnd_s(int x) { asm volatile("" : "+s"(x)); return x; }
namespace pg8 {
#define PG8_LAS __attribute__((address_space(3)))
typedef unsigned short bf16_t;
typedef short bf16x8 __attribute__((ext_vector_type(8)));
typedef float f32x4 __attribute__((ext_vector_type(4)));
typedef unsigned u32x4 __attribute__((ext_vector_type(4)));
constexpr int BM = 256, BK = 64, HALF = 128, HTB = HALF * BK * 2  , STAGE_BYTES = 8 * HTB, NXCD = 8, WGM = 8;

__host__ __device__ __forceinline__ int lds_byte(int r, int c) { const int st = (r >> 4) * 2 + (c >> 5), rr = r & 15, cc = c & 31, ob = rr * 64 + cc * 2; return st * 1024 + (ob ^ (((ob >> 9) & 1) << 5)); }
__host__ __device__ __forceinline__ void stage_rc(int b, int& R, int& C) { const int st = b / 1024, sb = b % 1024, swz = sb ^ (((sb >> 9) & 1) << 5); R = (st >> 1) * 16 + swz / 64; C = (st & 1) * 32 + (swz % 64) / 2; }
__host__ __device__ __forceinline__ int perm32(int rho) { const int n = rho >> 4, i = rho & 15; return 8 * (i >> 2) + 4 * n + (i & 3); }

struct Unit { int pm, pn; };
struct Gemm { const bf16_t* A; const bf16_t* Bt; int M, N, K; };

struct StaticOrder {
    int nM, nN, nwg, G, c;
    __host__ __device__ void init(int M, int N, int G_, int c_) { nM = M / BM; nN = N / BM; nwg = nM * nN; G = G_; c = c_; }
    __host__ __device__ bool next(int i, Unit& u) const {
        const long L = (long)i * G + c; if (L >= nwg) return false;
        int wgid = (int)L; { const int q = nwg / NXCD, r = nwg % NXCD, xcd = wgid % NXCD, off = wgid / NXCD; wgid = (xcd < r ? xcd * (q + 1) : r * (q + 1) + (xcd - r) * q) + off; }
        const int nig = WGM * nN, gid = wgid / nig, fm = gid * WGM, gsz = (nM - fm) < WGM ? (nM - fm) : WGM;
        u.pm = fm + ((wgid % nig) % gsz); u.pn = (wgid % nig) / gsz; return true;
    }
    __device__ __forceinline__ void a_ready(const Unit&) const {}
    __device__ __forceinline__ void done(const Unit&) const {}
};
__device__ __forceinline__ unsigned cvt_pk_bf16(float lo, float hi) { unsigned r; asm volatile("v_cvt_pk_bf16_f32 %0, %1, %2" : "=v"(r) : "v"(lo), "v"(hi)); return r; }
template <class Epi, class Sched, bool ALIGN_EPI = false, bool SP2 = false>
__device__ __forceinline__ void gemm_phase(PG8_LAS unsigned char* lds, const Gemm g, const Sched& S, const Epi& E, const int tid_in) {
    const int tid = tid_in, wid = __builtin_amdgcn_readfirstlane(tid >> 6), lane = tid & 63, wr = wid >> 2, wc = wid & 3, fr = lane & 15, fq = lane >> 4;
    const int K = g.K, nt = K / BK;
    unsigned voffA[2], voffB[2];
#pragma unroll
    for (int i = 0; i < 2; ++i) { int R, C; stage_rc(tid * 16 + i * 8192, R, C); const int Rb = Epi::PERM ? ((R & ~31) + perm32(R & 31)) : R;
        voffA[i] = (unsigned)(R * K + C) * 2u; voffB[i] = (unsigned)(Rb * K + C) * 2u; }
    const size_t kstep = (size_t)(BK * 2);
    const size_t hstep = (size_t)HALF * K * 2;
    const size_t tstep = 2 * hstep;
    const unsigned ldsw = (unsigned)wid * 1024u;
    const int aoff = lds_byte(wr * 64 + fr, fq * 8), boff = lds_byte(wc * 32 + fr, fq * 8);
#define PG8_SA(b, h) (((b) * 2 + (h)) * HTB)
#define PG8_SB(b, h) ((4 + (b) * 2 + (h)) * HTB)
#define PG8_STAGE(bufoff, gbase, voff) do { _Pragma("unroll") for (int _i = 0; _i < 2; ++_i) \
        __builtin_amdgcn_global_load_lds((const unsigned*)((const char*)(gbase) + (voff)[_i]), (PG8_LAS unsigned*)(lds + (bufoff) + ldsw + _i * 8192), 16, 0, 0); } while (0)
#define PG8_LDA(dst, b, h) do { _Pragma("unroll") for (int m = 0; m < 4; ++m) _Pragma("unroll") for (int k = 0; k < 2; ++k) dst[m][k] = *(const PG8_LAS bf16x8*)(lds + PG8_SA(b, h) + aoff + m * 2048 + k * 1024); } while (0)
#define PG8_LDB(dst, b, h) do { _Pragma("unroll") for (int n = 0; n < 2; ++n) _Pragma("unroll") for (int k = 0; k < 2; ++k) dst[n][k] = *(const PG8_LAS bf16x8*)(lds + PG8_SB(b, h) + boff + n * 2048 + k * 1024); } while (0)
#define PG8_MMA(ai, bj, At, Bt) do { __builtin_amdgcn_s_setprio(1); _Pragma("unroll") for (int m = 0; m < 4; ++m) _Pragma("unroll") for (int n = 0; n < 2; ++n) _Pragma("unroll") for (int k = 0; k < 2; ++k) \
        acc[ai][bj][m][n] = __builtin_amdgcn_mfma_f32_16x16x32_bf16(Bt[n][k], At[m][k], acc[ai][bj][m][n], 0, 0, 0); __builtin_amdgcn_s_setprio(0); } while (0)
#define PG8_WAIT_V(n) asm volatile("s_waitcnt vmcnt(" #n ")" ::: "memory")
#define PG8_WAIT_L(n) asm volatile("s_waitcnt lgkmcnt(" #n ")" ::: "memory")
#define PG8_BAR __builtin_amdgcn_s_barrier()
#define PG8_SCHED __builtin_amdgcn_sched_barrier(0)
    Unit cur, nxt; int ui = 0;
    if (!S.next(0, cur)) return;
    f32x4 acc[2][2][4][2];
#pragma unroll
    for (int a = 0; a < 2; ++a)
#pragma unroll
        for (int b = 0; b < 2; ++b)
#pragma unroll
            for (int m = 0; m < 4; ++m)
#pragma unroll
                for (int n = 0; n < 2; ++n) acc[a][b][m][n] = (f32x4){0.f, 0.f, 0.f, 0.f};
    bf16x8 At[4][2], B0[2][2], B1[2][2];
    const char* cA = (const char*)g.A + (size_t)cur.pm * tstep; const char* cB = (const char*)g.Bt + (size_t)cur.pn * tstep;
    S.a_ready(cur);
    if constexpr (SP2) {
        PG8_STAGE(PG8_SB(0, 0), cB, voffB); PG8_STAGE(PG8_SB(0, 1), cB + hstep, voffB); PG8_STAGE(PG8_SA(0, 0), cA, voffA); PG8_STAGE(PG8_SA(0, 1), cA + hstep, voffA);
        if (wr == 1) PG8_BAR;
        PG8_WAIT_V(2); PG8_BAR;
        PG8_STAGE(PG8_SB(1, 0), cB + kstep, voffB); PG8_STAGE(PG8_SA(1, 0), cA + kstep, voffA); PG8_STAGE(PG8_SB(1, 1), cB + hstep + kstep, voffB);
        PG8_WAIT_V(6); PG8_BAR;
    } else {
        PG8_STAGE(PG8_SB(0, 0), cB, voffB); PG8_STAGE(PG8_SA(0, 0), cA, voffA); PG8_STAGE(PG8_SB(0, 1), cB + hstep, voffB); PG8_STAGE(PG8_SA(0, 1), cA + hstep, voffA);
        if (wr == 1) PG8_BAR;
        PG8_WAIT_V(4); PG8_BAR;
        PG8_STAGE(PG8_SB(1, 0), cB + kstep, voffB); PG8_STAGE(PG8_SA(1, 0), cA + kstep, voffA); PG8_STAGE(PG8_SB(1, 1), cB + hstep + kstep, voffB);
        PG8_WAIT_V(6); PG8_BAR;
    }
    for (;;) {
        const bool has_next = S.next(ui + 1, nxt);
        const char* nA = has_next ? (const char*)g.A + (size_t)nxt.pm * tstep : cA; const char* nB = has_next ? (const char*)g.Bt + (size_t)nxt.pn * tstep : cB;
        for (int t = 0; t < nt; t += 2) {
            const bool last = (t == nt - 2);
            const char* a1 = cA + (size_t)(t + 1) * kstep;
            const char* a2 = last ? nA : cA + (size_t)(t + 2) * kstep; const char* b2 = last ? nB : cB + (size_t)(t + 2) * kstep;
            const char* a3 = a2 + kstep; const char* b3 = b2 + kstep;
            if (last && has_next) S.a_ready(nxt);
            if constexpr (SP2) {
            PG8_LDB(B0, 0, 0); PG8_LDB(B1, 0, 1); PG8_SCHED; PG8_LDA(At, 0, 0); PG8_STAGE(PG8_SA(1, 1), a1 + hstep, voffA);
            PG8_WAIT_V(8); PG8_WAIT_L(0); PG8_BAR; PG8_MMA(0, 0, At, B0); PG8_MMA(0, 1, At, B1); PG8_BAR; PG8_SCHED;
            PG8_LDA(At, 0, 1); PG8_STAGE(PG8_SB(0, 0), b2, voffB); PG8_STAGE(PG8_SB(0, 1), b2 + hstep, voffB); PG8_STAGE(PG8_SA(0, 0), a2, voffA);
            PG8_WAIT_V(8); PG8_WAIT_L(0); PG8_BAR; PG8_MMA(1, 0, At, B0); PG8_MMA(1, 1, At, B1); PG8_BAR; PG8_SCHED;
            PG8_LDB(B0, 1, 0); PG8_LDB(B1, 1, 1); PG8_SCHED; PG8_LDA(At, 1, 0); PG8_STAGE(PG8_SA(0, 1), a2 + hstep, voffA);
            PG8_WAIT_V(8); PG8_WAIT_L(0); PG8_BAR; PG8_MMA(0, 0, At, B0); PG8_MMA(0, 1, At, B1); PG8_BAR; PG8_SCHED;
            PG8_LDA(At, 1, 1); PG8_STAGE(PG8_SB(1, 0), b3, voffB); PG8_STAGE(PG8_SB(1, 1), b3 + hstep, voffB); PG8_STAGE(PG8_SA(1, 0), a3, voffA);
            PG8_WAIT_V(8); PG8_WAIT_L(0); PG8_BAR; PG8_MMA(1, 0, At, B0); PG8_MMA(1, 1, At, B1); PG8_BAR; PG8_SCHED;
            } else {
            PG8_LDB(B0, 0, 0); PG8_SCHED; PG8_LDA(At, 0, 0); PG8_STAGE(PG8_SA(1, 1), a1 + hstep, voffA);
            PG8_WAIT_L(8); PG8_BAR; PG8_WAIT_L(0); PG8_MMA(0, 0, At, B0); PG8_BAR; PG8_SCHED;
            PG8_LDB(B1, 0, 1); PG8_STAGE(PG8_SB(0, 0), b2, voffB);
            PG8_BAR; PG8_WAIT_L(0); PG8_MMA(0, 1, At, B1); PG8_BAR;
            PG8_LDA(At, 0, 1); PG8_STAGE(PG8_SA(0, 0), a2, voffA);
            PG8_BAR; PG8_WAIT_L(0); PG8_MMA(1, 0, At, B0); PG8_BAR; PG8_SCHED;
            PG8_STAGE(PG8_SB(0, 1), b2 + hstep, voffB);
            PG8_WAIT_V(6); PG8_BAR; PG8_MMA(1, 1, At, B1); PG8_BAR;
            PG8_LDB(B0, 1, 0); PG8_SCHED; PG8_LDA(At, 1, 0); PG8_STAGE(PG8_SA(0, 1), a2 + hstep, voffA);
            PG8_WAIT_L(8); PG8_BAR; PG8_WAIT_L(0); PG8_MMA(0, 0, At, B0); PG8_BAR; PG8_SCHED;
            PG8_LDB(B1, 1, 1); PG8_STAGE(PG8_SB(1, 0), b3, voffB);
            PG8_BAR; PG8_WAIT_L(0); PG8_MMA(0, 1, At, B1); PG8_BAR;
            PG8_LDA(At, 1, 1); PG8_STAGE(PG8_SA(1, 0), a3, voffA);
            PG8_BAR; PG8_WAIT_L(0); PG8_MMA(1, 0, At, B0); PG8_BAR; PG8_SCHED;
            PG8_STAGE(PG8_SB(1, 1), b3 + hstep, voffB);
            PG8_WAIT_V(6); PG8_BAR; PG8_MMA(1, 1, At, B1); PG8_BAR;
            }
        }
        if constexpr (ALIGN_EPI) { if (wr == 0) PG8_BAR; }
        if constexpr (!Epi::AFTER_DRAIN) { E(acc, cur, wr, wc, fr, fq); S.done(cur); }
        if (!has_next) break;
#pragma unroll
        for (int a = 0; a < 2; ++a)
#pragma unroll
            for (int b = 0; b < 2; ++b)
#pragma unroll
                for (int m = 0; m < 4; ++m)
#pragma unroll
                    for (int n = 0; n < 2; ++n) acc[a][b][m][n] = (f32x4){0.f, 0.f, 0.f, 0.f};
        cur = nxt; cA = nA; cB = nB; ++ui;
        if constexpr (ALIGN_EPI) { if (wr == 1) PG8_BAR; }
    }
    PG8_WAIT_V(0);
    if constexpr (!ALIGN_EPI) { if (wr == 0) PG8_BAR; }
    PG8_BAR;
    if constexpr (Epi::AFTER_DRAIN) { E.fused(acc, cur, wr, wc, fr, fq, lds, wid, lane); S.done(cur); }
#undef PG8_SA
#undef PG8_SB
#undef PG8_STAGE
#undef PG8_LDA
#undef PG8_LDB
#undef PG8_MMA
#undef PG8_WAIT_V
#undef PG8_WAIT_L
#undef PG8_BAR
#undef PG8_SCHED
}
}

#ifndef MK_MULTI
#define MK_MULTI 0
#endif

constexpr int NW = 8, NT = 512;
constexpr int D = 1024, FF = 4096, SEQ = 8192, MPR = 16384, NS = 128, MV = MPR + NS, MP = 16640;
constexpr int NPROJ = 4112, NPROJ_PAD = 4352, NQKV2 = 2304, NQ = 1536;
constexpr float EPS = 1e-6f;
constexpr size_t O_YP = 0, O_YS = 16777216, O_PREC = 16908288, O_PCONV = 17432576, O_PKV0 = 17469440, O_PKV1 = 17534976, O_PKV2 = 17797120,
                 O_SREC = 18845696, O_SCONV = 52400128, O_SKV0 = 54759424, O_SKV1 = 58953728, O_SKV2 = 75730944, O_END = 142839808;
constexpr size_t MiB = 1u << 20;
constexpr size_t WS_WIN = 1 * MiB, WS_WOUT = 19 * MiB, WS_WUP = 23 * MiB, WS_WDN = 55 * MiB, WS_WQKV2 = 87 * MiB, WS_WQ3 = 92 * MiB, WS_WO = 95 * MiB;
constexpr size_t WS_X = 98 * MiB, WS_XN = 164 * MiB, WS_BIG = 198 * MiB, WS_BA = 329 * MiB, WS_O = 331 * MiB, WS_OG = 397 * MiB;
constexpr size_t WS_CW = 430 * MiB, WS_CQD = 462 * MiB, WS_CKDT = 494 * MiB, WS_CATT = 526 * MiB, WS_CU = 542 * MiB, WS_CDL = 606 * MiB;
constexpr size_t WS_QB = 607 * MiB, WS_KB = 655 * MiB, WS_VB = 667 * MiB, WS_QS = 679 * MiB, WS_OB = 680 * MiB, WS_LSE = 729 * MiB, WS_ATT = 731 * MiB, WS_SS = 748 * MiB, WS_END = 749 * MiB;
constexpr int LDS_BYTES = 147456;

#define LAS __attribute__((address_space(3)))
typedef unsigned short bf16;
typedef unsigned v4u __attribute__((ext_vector_type(4)));
typedef unsigned v2u __attribute__((ext_vector_type(2)));
typedef float f32x4 __attribute__((ext_vector_type(4)));
typedef short bf16x8 __attribute__((ext_vector_type(8)));

typedef float f32x2_t __attribute__((ext_vector_type(2)));
typedef __bf16 bf16x2_t __attribute__((ext_vector_type(2)));
__device__ __forceinline__ unsigned pk2(float lo, float hi) { const f32x2_t v = {lo, hi}; const bf16x2_t r = __builtin_convertvector(v, bf16x2_t); return __builtin_bit_cast(unsigned, r); }
__device__ __forceinline__ unsigned f2bf(float f) { return pk2(f, 0.f) & 0xffffu; }
__device__ __forceinline__ float bflo(unsigned w) { return __builtin_bit_cast(float, w << 16); }
__device__ __forceinline__ float bfhi(unsigned w) { return __builtin_bit_cast(float, w & 0xffff0000u); }
__device__ __forceinline__ float bf2f(bf16 h) { return __builtin_bit_cast(float, (unsigned)h << 16); }
template <int M> __device__ __forceinline__ float shx(float v, int lane) {
    if constexpr (M < 32) return __builtin_bit_cast(float, __builtin_amdgcn_ds_swizzle(__builtin_bit_cast(int, v), (M << 10) | 0x1f));
    else return __builtin_bit_cast(float, __builtin_amdgcn_ds_bpermute((lane ^ 32) << 2, __builtin_bit_cast(int, v)));
}
__device__ __forceinline__ float wave_sum(float v, int lane) {
    v += shx<1>(v, lane); v += shx<2>(v, lane); v += shx<4>(v, lane); v += shx<8>(v, lane); v += shx<16>(v, lane); v += shx<32>(v, lane);
    return v;
}
__device__ __forceinline__ float wave_max(float v, int lane) {
    v = fmaxf(v, shx<1>(v, lane)); v = fmaxf(v, shx<2>(v, lane)); v = fmaxf(v, shx<4>(v, lane)); v = fmaxf(v, shx<8>(v, lane)); v = fmaxf(v, shx<16>(v, lane)); v = fmaxf(v, shx<32>(v, lane));
    return v;
}
__device__ __forceinline__ float silu_f(float x) { return x * __builtin_amdgcn_rcpf(1.f + __expf(-x)); }
#define LDSBAR() do { asm volatile("s_waitcnt lgkmcnt(0)" ::: "memory"); __builtin_amdgcn_s_barrier(); asm volatile("" ::: "memory"); } while (0)
#define MFMA16(a, b, c) __builtin_amdgcn_mfma_f32_16x16x32_bf16((a), (b), (c), 0, 0, 0)

template <class T> __device__ __forceinline__ T* lnd(T* q) { __attribute__((address_space(1))) T* g = (__attribute__((address_space(1))) T*)q; asm volatile("" : "+s"(g)); return (T*)g; }
struct Par { const float* in[22]; float* out; unsigned char* ws; int ph_lo, ph_hi; };
typedef __attribute__((address_space(4))) Par CPar;

__device__ __forceinline__ void epi_rstd(const float* ss, int row0, float (&r)[2][4]) {
#pragma unroll
    for (int ai = 0; ai < 2; ++ai)
#pragma unroll
        for (int m = 0; m < 4; ++m) r[ai][m] = rsqrtf(ss[row0 + ai * 128 + m * 16] * (1.f / D) + EPS);
}
struct EpiRelu2 {
    static constexpr bool PERM = true, AFTER_DRAIN = false;
    bf16* O; int ldc; const float* ss;
    __device__ __forceinline__ void operator()(const f32x4 (&acc)[2][2][4][2], const pg8::Unit& u, int wr, int wc, int fr, int fq) const {
        const int row0 = u.pm * 256 + wr * 64 + fr, col0 = u.pn * 256 + wc * 32 + 8 * fq;
        float rs[2][4]; epi_rstd(ss, row0, rs);
#pragma unroll
        for (int ai = 0; ai < 2; ++ai)
#pragma unroll
            for (int m = 0; m < 4; ++m) { bf16* rowp = O + (size_t)(row0 + ai * 128 + m * 16) * ldc + col0;
#pragma unroll
                for (int bj = 0; bj < 2; ++bj) { f32x4 v0 = acc[ai][bj][m][0] * rs[ai][m], v1 = acc[ai][bj][m][1] * rs[ai][m];
#pragma unroll
                    for (int e = 0; e < 4; ++e) { float a = fmaxf(v0[e], 0.f), b = fmaxf(v1[e], 0.f); v0[e] = a * a; v1[e] = b * b; }
                    v4u w; w.x = pk2(v0[0], v0[1]); w.y = pk2(v0[2], v0[3]); w.z = pk2(v1[0], v1[1]); w.w = pk2(v1[2], v1[3]);
                    *(v4u*)(rowp + bj * 128) = w; } }
    }
};
struct EpiRes {
    static constexpr bool PERM = true, AFTER_DRAIN = false;
    float* X; bf16* XB; float* ss; const float* Xsrc;
    __device__ __forceinline__ void operator()(const f32x4 (&acc)[2][2][4][2], const pg8::Unit& u, int wr, int wc, int fr, int fq) const {
        const int row0 = u.pm * 256 + wr * 64 + fr, col0 = u.pn * 256 + wc * 32 + 8 * fq, lane = fr + 16 * fq;
#pragma unroll
        for (int ai = 0; ai < 2; ++ai) {
            f32x4 xa[4][2][2];
#pragma unroll
            for (int m = 0; m < 4; ++m)
#pragma unroll
                for (int bj = 0; bj < 2; ++bj) { const f32x4* p0 = (const f32x4*)(Xsrc + (size_t)(row0 + ai * 128 + m * 16) * D + col0 + bj * 128); xa[m][bj][0] = p0[0]; xa[m][bj][1] = p0[1]; }
#pragma unroll
            for (int m = 0; m < 4; ++m) { const int row = row0 + ai * 128 + m * 16; float* rowp = X + (size_t)row * D + col0; bf16* xb = XB + (size_t)row * D + col0; float sq = 0.f;
#pragma unroll
                for (int bj = 0; bj < 2; ++bj) { f32x4* p0 = (f32x4*)(rowp + bj * 128); const f32x4 a = xa[m][bj][0] + acc[ai][bj][m][0], b = xa[m][bj][1] + acc[ai][bj][m][1]; p0[0] = a; p0[1] = b;
                    sq += (a[0] * a[0] + a[1] * a[1]) + (a[2] * a[2] + a[3] * a[3]) + (b[0] * b[0] + b[1] * b[1]) + (b[2] * b[2] + b[3] * b[3]);
                    v4u w; w.x = pk2(a[0], a[1]); w.y = pk2(a[2], a[3]); w.z = pk2(b[0], b[1]); w.w = pk2(b[2], b[3]);
                    *(v4u*)(xb + bj * 128) = w; }
                sq += shx<16>(sq, lane); sq += shx<32>(sq, lane);
                if (fq == 0) unsafeAtomicAdd(ss + row, sq); }
        }
    }
};
struct EpiProj {
    static constexpr bool PERM = true, AFTER_DRAIN = false;
    bf16* QKVZ; const float* ss;
    __device__ __forceinline__ void operator()(const f32x4 (&acc)[2][2][4][2], const pg8::Unit& u, int wr, int wc, int fr, int fq) const {
        const int row0 = u.pm * 256 + wr * 64 + fr, col0 = u.pn * 256 + wc * 32 + 8 * fq;
        float rs[2][4]; epi_rstd(ss, row0, rs);
#pragma unroll
        for (int ai = 0; ai < 2; ++ai)
#pragma unroll
            for (int m = 0; m < 4; ++m) { const int row = row0 + ai * 128 + m * 16;
#pragma unroll
                for (int bj = 0; bj < 2; ++bj) { const int c = col0 + bj * 128; const f32x4 v0 = acc[ai][bj][m][0] * rs[ai][m], v1 = acc[ai][bj][m][1] * rs[ai][m];
                    v4u w; w.x = pk2(v0[0], v0[1]); w.y = pk2(v0[2], v0[3]); w.z = pk2(v1[0], v1[1]); w.w = pk2(v1[2], v1[3]);
                    *(v4u*)(QKVZ + (size_t)row * 4096 + c) = w; } }
    }
};
struct EpiQKV {
    static constexpr bool PERM = true, AFTER_DRAIN = false;
    bf16 *Qb, *Kb, *Vb; float* out; const float* ss;
    __device__ __forceinline__ void operator()(const f32x4 (&acc)[2][2][4][2], const pg8::Unit& u, int wr, int wc, int fr, int fq) const {
        const int row0 = u.pm * 256 + wr * 64 + fr, col0 = u.pn * 256 + wc * 32 + 8 * fq;
        float rs[2][4]; epi_rstd(ss, row0, rs);
#pragma unroll
        for (int ai = 0; ai < 2; ++ai)
#pragma unroll
            for (int m = 0; m < 4; ++m) { const int row = row0 + ai * 128 + m * 16; const int n = row >> 13, i = row & 8191;
#pragma unroll
                for (int bj = 0; bj < 2; ++bj) { const int c = col0 + bj * 128; const f32x4 v0 = acc[ai][bj][m][0] * rs[ai][m], v1 = acc[ai][bj][m][1] * rs[ai][m];
                    v4u w; w.x = pk2(v0[0], v0[1]); w.y = pk2(v0[2], v0[3]); w.z = pk2(v1[0], v1[1]); w.w = pk2(v1[2], v1[3]);
                    if (c < NQ) {
                        const int b = c >> 9, head = (c >> 6) & 7, dim0 = c & 63, sh = 2 * b, pr = ((i & ((1 << sh) - 1)) << (13 - sh)) + (i >> sh);
                        *(v4u*)(Qb + ((size_t)(((b * 2 + n) * 8 + head) * 8192 + pr)) * 64 + dim0) = w;
                    } else {
                        const int cc = c - NQ, b = cc >> 8, kvsel = (cc >> 7) & 1, g = (cc >> 6) & 1, dim0 = cc & 63, Wb = 128 << (2 * b), sh = 2 * b, pr = ((i & ((1 << sh) - 1)) << (13 - sh)) + (i >> sh);
                        const size_t ob = (b == 0) ? O_PKV0 : (b == 1 ? O_PKV1 : O_PKV2);
                        bf16* dst = kvsel ? Vb : Kb;
                        *(v4u*)(dst + ((size_t)(((b * 2 + n) * 2 + g) * 8192 + pr)) * 64 + dim0) = w;
                        if (i >= SEQ - Wb) { f32x4* p0 = (f32x4*)(out + ob + ((size_t)n * Wb + (i - (SEQ - Wb))) * 256 + (cc & 255)); p0[0] = v0; p0[1] = v1; }
                    } } }
    }
};

template <bool AF32> __device__ __forceinline__ f32x4 mini_core(const void* A, int lda, int row, const bf16* Bt, int ldb, int brow, int k0, int klen, int fq, int lane, float& ssq) {
    f32x4 acc = {0.f, 0.f, 0.f, 0.f}; float sq = 0.f;
    const bf16* bp = Bt + (size_t)brow * ldb + k0 + fq * 8;
    if constexpr (AF32) {
        const float* ap = (const float*)A + (size_t)row * lda + k0 + fq * 8;
#pragma unroll 4
        for (int ks = 0; ks < klen / 32; ++ks) { const f32x4 x0 = *(const f32x4*)(ap + ks * 32), x1 = *(const f32x4*)(ap + ks * 32 + 4); const bf16x8 bf = *(const bf16x8*)(bp + ks * 32);
            sq += (x0[0] * x0[0] + x0[1] * x0[1]) + (x0[2] * x0[2] + x0[3] * x0[3]) + (x1[0] * x1[0] + x1[1] * x1[1]) + (x1[2] * x1[2] + x1[3] * x1[3]);
            v4u aw; aw.x = pk2(x0[0], x0[1]); aw.y = pk2(x0[2], x0[3]); aw.z = pk2(x1[0], x1[1]); aw.w = pk2(x1[2], x1[3]);
            acc = MFMA16(bf, __builtin_bit_cast(bf16x8, aw), acc); }
        sq += shx<16>(sq, lane); sq += shx<32>(sq, lane);
    } else {
        const bf16* ap = (const bf16*)A + (size_t)row * lda + k0 + fq * 8;
#pragma unroll 4
        for (int ks = 0; ks < klen / 32; ++ks) { const bf16x8 af = *(const bf16x8*)(ap + ks * 32); const bf16x8 bf = *(const bf16x8*)(bp + ks * 32); acc = MFMA16(bf, af, acc); }
    }
    ssq = sq; return acc;
}
__device__ __forceinline__ void mini_items(const CPar& p, int kind, int l, int k, int bid, int G, int tid, LAS unsigned char* lds) {
    unsigned char* ws = lnd(p.ws);
    const int w = tid >> 6, lane = tid & 63, fr = lane & 15, fq = lane >> 4;
    float* X = (float*)(ws + WS_X);
    if (kind == 0) {
        const bf16* Bt = (const bf16*)(ws + WS_WIN) + (size_t)l * NPROJ_PAD * D; bf16* QKVZ = (bf16*)(ws + WS_BIG); float* BA = (float*)(ws + WS_BA);
        for (int it = G - 1 - bid; it < 257 + 128; it += G) {
            float ssq;
            if (it < 257) { const int c0 = it * 16, r = 16 * w + fr;
                const f32x4 acc = mini_core<true>(X, D, MPR + r, Bt, D, c0 + fr, 0, D, fq, lane, ssq); const f32x4 v = acc * rsqrtf(ssq * (1.f / D) + EPS); const int col = c0 + 4 * fq;
                if (col < 4096) { v2u o; o.x = pk2(v[0], v[1]); o.y = pk2(v[2], v[3]); *(v2u*)(QKVZ + (size_t)(MPR + r) * 4096 + col) = o; }
                else *(f32x4*)(BA + (size_t)(MPR + r) * 16 + (col - 4096)) = v;
            } else { const int row = (it - 257) * 128 + 16 * w + fr;
                const f32x4 acc = mini_core<false>(ws + WS_XN, D, row, Bt, D, 4096 + fr, 0, D, fq, lane, ssq);
                const float rstd = rsqrtf(((const float*)(ws + WS_SS))[(size_t)(2 * l) * MPR + row] * (1.f / D) + EPS);
                *(f32x4*)(BA + (size_t)row * 16 + 4 * fq) = acc * rstd; }
        }
    } else if (kind == 1) {
        const bf16* A; const bf16* Bt; int K;
        if (k == 5) { A = (const bf16*)(ws + WS_OG); Bt = (const bf16*)(ws + WS_WOUT) + (size_t)l * D * D; K = D; }
        else if (k == 13) { A = (const bf16*)(ws + WS_ATT); Bt = (const bf16*)(ws + WS_WO) + (size_t)(l - 2) * D * 512; K = 512; }
        else { A = (const bf16*)(ws + WS_BIG); Bt = (const bf16*)(ws + WS_WDN) + (size_t)l * D * FF; K = FF; }
        LAS f32x4* red = (LAS f32x4*)lds;
        for (int it = G - 1 - bid; it < 256; it += G) { const int c0 = (it >> 2) * 16, r = (it & 3) * 32 + 16 * (w & 1) + fr, kq = w >> 1; float ssq;
            const f32x4 acc = mini_core<false>(A, K, MPR + r, Bt, K, c0 + fr, kq * (K / 4), K / 4, fq, lane, ssq);
            if (kq) red[((kq - 1) * 2 + (w & 1)) * 64 + lane] = acc;
            __syncthreads();
            if (!kq) { f32x4* xp = (f32x4*)(X + (size_t)(MPR + r) * D + c0 + 4 * fq); *xp = *xp + ((acc + red[(w & 1) * 64 + lane]) + (red[(2 + (w & 1)) * 64 + lane] + red[(4 + (w & 1)) * 64 + lane])); }
            __syncthreads(); }
    } else if (kind == 2) {
        const bf16* Bt = (const bf16*)(ws + WS_WUP) + (size_t)l * FF * D; bf16* H = (bf16*)(ws + WS_BIG);
        for (int it = G - 1 - bid; it < 256; it += G) { const int c0 = it * 16, r = 16 * w + fr; float ssq;
            const f32x4 acc = mini_core<true>(X, D, MPR + r, Bt, D, c0 + fr, 0, D, fq, lane, ssq); const f32x4 v = acc * rsqrtf(ssq * (1.f / D) + EPS);
            float t[4];
#pragma unroll
            for (int e = 0; e < 4; ++e) { const float a = fmaxf(v[e], 0.f); t[e] = a * a; }
            v2u o; o.x = pk2(t[0], t[1]); o.y = pk2(t[2], t[3]); *(v2u*)(H + (size_t)(MPR + r) * FF + c0 + 4 * fq) = o; }
    } else {
        const bf16* Bt = (const bf16*)(ws + (l == 2 ? WS_WQKV2 : WS_WQ3)); const int nch = (l == 2 ? NQKV2 : NQ) / 16; bf16* Qs = (bf16*)(ws + WS_QS); float* out = lnd(p.out);
        for (int it = G - 1 - bid; it < nch; it += G) { const int c0 = it * 16, r = 16 * w + fr; float ssq;
            const f32x4 acc = mini_core<true>(X, D, MPR + r, Bt, D, c0 + fr, 0, D, fq, lane, ssq); const f32x4 v = acc * rsqrtf(ssq * (1.f / D) + EPS); const int col = c0 + 4 * fq;
            if (col < NQ) { v2u o; o.x = pk2(v[0], v[1]); o.y = pk2(v[2], v[3]); *(v2u*)(Qs + (size_t)r * NQ + col) = o; }
            else { const int cc = col - NQ, b = cc >> 8, Wb = 128 << (2 * b); const size_t os = (b == 0) ? O_SKV0 : (b == 1 ? O_SKV1 : O_SKV2);
                *(f32x4*)(out + os + ((size_t)r * Wb + (Wb - 1)) * 256 + (cc & 255)) = v; } }
    }
}

__device__ __forceinline__ void p0_transpose_item(const float* W, int K, int Nsrc, int Npad, const float* gain, bf16* WT, int row_off, LAS float* scr, int item, int lane) {
    const int nblk = Npad / 64, kb = item / nblk, nb = item % nblk, k0 = 64 * kb, n0 = 64 * nb;
    const int nn = n0 + 4 * (lane & 15);
#pragma unroll 8
    for (int i = 0; i < 16; ++i) { const int kk = 4 * i + (lane >> 4); f32x4 v = {0.f, 0.f, 0.f, 0.f};
        if (nn < Nsrc) v = *(const f32x4*)(W + (size_t)(k0 + kk) * Nsrc + nn);
        if (gain) v = v * gain[k0 + kk];
        LAS float* d = scr + kk * 65 + 4 * (lane & 15); d[0] = v[0]; d[1] = v[1]; d[2] = v[2]; d[3] = v[3]; }
    asm volatile("s_waitcnt lgkmcnt(0)" ::: "memory");
    const int c = lane & 7;
#pragma unroll
    for (int j = 0; j < 8; ++j) { const int n = (lane >> 3) + 8 * j; const LAS float* sp = scr + (8 * c) * 65 + n;
        v4u o; o.x = pk2(sp[0 * 65], sp[1 * 65]); o.y = pk2(sp[2 * 65], sp[3 * 65]); o.z = pk2(sp[4 * 65], sp[5 * 65]); o.w = pk2(sp[6 * 65], sp[7 * 65]);
        *(v4u*)(WT + (size_t)(row_off + n0 + n) * K + k0 + 8 * c) = o; }
    asm volatile("s_waitcnt lgkmcnt(0)" ::: "memory");
}
constexpr int I_IN = (D / 64) * (NPROJ_PAD / 64), I_OUT = (D / 64) * (D / 64), I_UP = (D / 64) * (FF / 64), I_DN = (FF / 64) * (D / 64),
              I_Q = (D / 64) * (NQ / 64), I_KV = (D / 64) * (768 / 64), I_O = (512 / 64) * (D / 64);
constexpr int P0_NA = I_IN + I_OUT + I_UP + I_DN, P0_NITEMS = 2 * I_IN + 2 * I_OUT + 4 * I_UP + 4 * I_DN + 2 * I_Q + I_KV + 2 * I_O;
__device__ __forceinline__ void p0_weights(const CPar& p, LAS unsigned char* lds, int gw, int NGW, int wave, int lane, int first, int last) {
    LAS float* scr = (LAS float*)(lds + wave * 17408);
    unsigned char* ws = lnd(p.ws);
    for (int it = first + gw; it < last; it += NGW) {
        int r = it, type, l = 0;
        if (r < P0_NA) { if (r < I_IN) type = 0; else if ((r -= I_IN) < I_OUT) type = 1; else if ((r -= I_OUT) < I_UP) type = 2; else { r -= I_UP; type = 3; } }
        else { r -= P0_NA; l = 1;
            if (r < I_IN) type = 0; else if ((r -= I_IN) < I_OUT) type = 1;
            else if ((r -= I_OUT) < 3 * I_UP) { type = 2; l = 1 + r / I_UP; r %= I_UP; }
            else if ((r -= 3 * I_UP) < 3 * I_DN) { type = 3; l = 1 + r / I_DN; r %= I_DN; }
            else if ((r -= 3 * I_DN) < I_Q) type = 4; else if ((r -= I_Q) < I_KV) type = 5; else if ((r -= I_KV) < I_Q) type = 6; else { r -= I_Q; type = 7; l = r / I_O; r %= I_O; } }
        if (type == 0) p0_transpose_item(lnd(p.in[9]) + (size_t)l * D * NPROJ, D, NPROJ, NPROJ_PAD, lnd(p.in[7]) + l * D, (bf16*)(ws + WS_WIN) + (size_t)l * NPROJ_PAD * D, 0, scr, r, lane);
        else if (type == 1) p0_transpose_item(lnd(p.in[14]) + (size_t)l * D * D, D, D, D, nullptr, (bf16*)(ws + WS_WOUT) + (size_t)l * D * D, 0, scr, r, lane);
        else if (type == 2) p0_transpose_item(lnd(p.in[19]) + (size_t)l * D * FF, D, FF, FF, lnd(p.in[8]) + l * D, (bf16*)(ws + WS_WUP) + (size_t)l * FF * D, 0, scr, r, lane);
        else if (type == 3) p0_transpose_item(lnd(p.in[20]) + (size_t)l * FF * D, FF, D, D, nullptr, (bf16*)(ws + WS_WDN) + (size_t)l * D * FF, 0, scr, r, lane);
        else if (type == 4) p0_transpose_item(lnd(p.in[17]), D, NQ, NQ, lnd(p.in[7]) + 2 * D, (bf16*)(ws + WS_WQKV2), 0, scr, r, lane);
        else if (type == 5) p0_transpose_item(lnd(p.in[16]), D, 768, 768, lnd(p.in[15]), (bf16*)(ws + WS_WQKV2), NQ, scr, r, lane);
        else if (type == 6) p0_transpose_item(lnd(p.in[17]) + (size_t)D * NQ, D, NQ, NQ, lnd(p.in[7]) + 3 * D, (bf16*)(ws + WS_WQ3), 0, scr, r, lane);
        else p0_transpose_item(lnd(p.in[18]) + (size_t)l * 512 * D, 512, D, D, nullptr, (bf16*)(ws + WS_WO) + (size_t)l * D * 512, 0, scr, r, lane);
    }
}
__device__ __forceinline__ void p0_prologue(const CPar& p, LAS unsigned char* lds, int gw, int NGW, int wave, int lane) {
    unsigned char* ws = lnd(p.ws);
    float* X = (float*)(ws + WS_X); bf16* XN = (bf16*)(ws + WS_XN); float* SS = (float*)(ws + WS_SS);
    for (int m = gw; m < MV; m += NGW) {
        const float* src = (m < MPR) ? lnd(p.in[0]) + (size_t)m * D : lnd(p.in[1]) + (size_t)(m - MPR) * D;
        const f32x4* xr = (const f32x4*)src + lane; f32x4 v[4]; float s = 0.f;
#pragma unroll
        for (int j = 0; j < 4; ++j) { v[j] = xr[64 * j]; s += (v[j].x * v[j].x + v[j].y * v[j].y) + (v[j].z * v[j].z + v[j].w * v[j].w); }
        if (m >= MPR) { f32x4* xo = (f32x4*)(X + (size_t)m * D) + lane;
#pragma unroll
            for (int j = 0; j < 4; ++j) xo[64 * j] = v[j]; }
        if (m < MPR) { s = wave_sum(s, lane); v2u* o8 = (v2u*)(XN + (size_t)m * D) + lane;
#pragma unroll
            for (int j = 0; j < 4; ++j) { v2u o; o.x = pk2(v[j].x, v[j].y); o.y = pk2(v[j].z, v[j].w); o8[64 * j] = o; }
            if (lane == 0) SS[m] = s; }
    }
    for (int e = gw * 64 + lane; e < 8 * MPR; e += NGW * 64) __hip_atomic_store(SS + MPR + e, 0.f, __ATOMIC_RELAXED, __HIP_MEMORY_SCOPE_AGENT);
}
__device__ __forceinline__ void final_norm(const float* X, const float* gain, float* out, int gw, int NGW, int lane) {
    for (int m = gw; m < MV; m += NGW) {
        const f32x4* xr = (const f32x4*)(X + (size_t)m * D) + lane; f32x4 v[4]; float s = 0.f;
#pragma unroll
        for (int j = 0; j < 4; ++j) { v[j] = xr[64 * j]; s += (v[j].x * v[j].x + v[j].y * v[j].y) + (v[j].z * v[j].z + v[j].w * v[j].w); }
        const float rstd = rsqrtf(wave_sum(s, lane) * (1.f / D) + EPS);
        f32x4* o = (f32x4*)(out + (size_t)m * D) + lane; const f32x4* gp = (const f32x4*)gain + lane;
#pragma unroll
        for (int j = 0; j < 4; ++j) { const f32x4 g = gp[64 * j]; o[64 * j] = v[j] * rstd * g; }
    }
}

__device__ __forceinline__ void gdn_prep_pair(const CPar& p, int l, int pi, LAS unsigned char* lds, int tid_) {
    const int tid = lnd_v(tid_);
    const int sub = tid >> 8, t = tid & 255, wv = t >> 6, lane = t & 63, fr = lane & 15, fq = lane >> 4;
    const int item = 2 * pi + sub, n = item >> 10, c = (item >> 3) & 127, h = item & 7, sid = ((n * 8 + h) << 7) + c;
    LAS unsigned char* base = lds + sub * 70400;
    LAS bf16* QT = (LAS bf16*)base; LAS bf16* KT = QT + 64 * 136; LAS bf16* VT = KT + 64 * 136;
    LAS float* LM = (LAS float*)(base + 3 * 17408); LAS float* GB = LM + 64 * 68;
    unsigned char* ws = lnd(p.ws);
    const bf16* qkvz = (const bf16*)(ws + WS_BIG); const float* BA = (const float*)(ws + WS_BA);
    const float* cw = lnd(p.in[10]) + (size_t)l * 4 * 3072;
    float braw = 0.f, araw = 0.f;
    if (wv == 0) { const size_t m = (size_t)n * SEQ + c * 64 + lane; braw = BA[m * 16 + h]; araw = BA[m * 16 + 8 + h]; }
#pragma unroll 1
    for (int part = 0; part < 3; ++part) {
        const int col = part * 1024 + h * 128 + fr * 8;
        float w[4][8];
#pragma unroll
        for (int jj = 0; jj < 4; ++jj) { const f32x4 a = *(const f32x4*)(cw + jj * 3072 + col), b = *(const f32x4*)(cw + jj * 3072 + col + 4);
            w[jj][0] = a.x; w[jj][1] = a.y; w[jj][2] = a.z; w[jj][3] = a.w; w[jj][4] = b.x; w[jj][5] = b.y; w[jj][6] = b.z; w[jj][7] = b.w; }
        LAS bf16* tile = (part == 0) ? QT : (part == 1 ? KT : VT);
        v4u xx[4][4];
#pragma unroll
        for (int ps = 0; ps < 4; ++ps)
#pragma unroll
            for (int jj = 0; jj < 4; ++jj) { const int ii = c * 64 + ps * 16 + wv * 4 + fq - 3 + jj, iic = ii < 0 ? 0 : ii;
                xx[ps][jj] = *(const v4u*)(qkvz + ((size_t)n * SEQ + iic) * 4096 + col); }
#pragma unroll
        for (int ps = 0; ps < 4; ++ps) {
            const int r = ps * 16 + wv * 4 + fq, i = c * 64 + r;
            float a[8];
#pragma unroll
            for (int e = 0; e < 8; ++e) a[e] = 0.f;
#pragma unroll
            for (int jj = 0; jj < 4; ++jj) { const v4u x = xx[ps][jj]; const float gd = (i - 3 + jj >= 0) ? 1.f : 0.f;
                a[0] += gd * w[jj][0] * bflo(x.x); a[1] += gd * w[jj][1] * bfhi(x.x); a[2] += gd * w[jj][2] * bflo(x.y); a[3] += gd * w[jj][3] * bfhi(x.y);
                a[4] += gd * w[jj][4] * bflo(x.z); a[5] += gd * w[jj][5] * bfhi(x.z); a[6] += gd * w[jj][6] * bflo(x.w); a[7] += gd * w[jj][7] * bfhi(x.w); }
            float ss = 0.f;
#pragma unroll
            for (int e = 0; e < 8; ++e) { a[e] = silu_f(a[e]); ss += a[e] * a[e]; }
            if (part < 2) {
                ss += shx<1>(ss, lane); ss += shx<2>(ss, lane); ss += shx<4>(ss, lane); ss += shx<8>(ss, lane);
                const float sc = rsqrtf(ss + EPS) * (part == 0 ? 0.08838834764831845f : 1.f);
#pragma unroll
                for (int e = 0; e < 8; ++e) a[e] *= sc;
            }
            v4u o; o.x = pk2(a[0], a[1]); o.y = pk2(a[2], a[3]); o.z = pk2(a[4], a[5]); o.w = pk2(a[6], a[7]);
            *(LAS v4u*)(tile + r * 136 + fr * 8) = o;
        }
    }
    if (wv == 0) {
        const float beta = 1.f / (1.f + expf(-braw));
        const float xx = araw + lnd(p.in[12])[l * 8 + h]; const float sp = xx > 20.f ? xx : log1pf(expf(xx));
        float g = -expf(lnd(p.in[11])[l * 8 + h]) * sp;
#pragma unroll
        for (int o = 1; o < 64; o <<= 1) { const float y = __builtin_bit_cast(float, __builtin_amdgcn_ds_bpermute(((lane - o) & 63) << 2, __builtin_bit_cast(int, g))); if (lane >= o) g += y; }
        GB[lane] = g; GB[64 + lane] = beta;
    }
    LDSBAR();
    {
        bf16x8 bk[4], bq[4];
#pragma unroll
        for (int ks = 0; ks < 4; ++ks) { bk[ks] = *(const LAS bf16x8*)(KT + (16 * wv + fr) * 136 + ks * 32 + fq * 8); bq[ks] = *(const LAS bf16x8*)(QT + (16 * wv + fr) * 136 + ks * 32 + fq * 8); }
        const int i = 16 * wv + fr; const float Gi = GB[i], bi = GB[64 + i];
        bf16* attn = (bf16*)(ws + WS_CATT) + (size_t)sid * 4096;
#pragma unroll
        for (int jt = 0; jt < 4; ++jt) {
            f32x4 Lv = {0.f, 0.f, 0.f, 0.f}, Av = {0.f, 0.f, 0.f, 0.f};
            if (jt <= wv) {
                f32x4 akk = {0.f, 0.f, 0.f, 0.f}, aqk = {0.f, 0.f, 0.f, 0.f};
#pragma unroll
                for (int ks = 0; ks < 4; ++ks) { const bf16x8 a = *(const LAS bf16x8*)(KT + (16 * jt + fr) * 136 + ks * 32 + fq * 8); akk = MFMA16(a, bk[ks], akk); aqk = MFMA16(a, bq[ks], aqk); }
#pragma unroll
                for (int e = 0; e < 4; ++e) { const int j = 16 * jt + 4 * fq + e; const float dd = __expf(fminf(Gi - GB[j], 0.f));
                    Lv[e] = (i > j) ? bi * akk[e] * dd : 0.f; Av[e] = (i >= j) ? aqk[e] * dd : 0.f; }
            }
#pragma unroll
            for (int e = 0; e < 4; ++e) LM[(16 * jt + 4 * fq + e) * 68 + i] = Lv[e];
            v2u o; o.x = pk2(Av[0], Av[1]); o.y = pk2(Av[2], Av[3]);
            *(v2u*)(attn + i * 64 + 16 * jt + 4 * fq) = o;
        }
    }
    LDSBAR();
    {
        float u[64];
        if (t < 128) {
#pragma unroll
            for (int i = 0; i < 64; ++i) u[i] = bf2f(VT[i * 136 + t]) * GB[64 + i];
        } else {
#pragma unroll
            for (int i = 0; i < 64; ++i) u[i] = bf2f(KT[i * 136 + (t - 128)]) * GB[64 + i] * __expf(GB[i]);
        }
        {
            f32x2_t u2[32];
#pragma unroll
            for (int k2 = 0; k2 < 32; ++k2) u2[k2] = (f32x2_t){u[2 * k2], u[2 * k2 + 1]};
#pragma unroll
            for (int j = 0; j < 63; ++j) {
                const float ujs = (j & 1) ? u2[j >> 1].y : u2[j >> 1].x; const f32x2_t uj = {ujs, ujs};
#pragma unroll
                for (int i4 = (j + 1) / 4; i4 < 16; ++i4) { const f32x4 lv = *(const LAS f32x4*)(LM + j * 68 + 4 * i4);
                    u2[2 * i4] -= (f32x2_t){lv.x, lv.y} * uj; u2[2 * i4 + 1] -= (f32x2_t){lv.z, lv.w} * uj; }
                __builtin_amdgcn_sched_barrier(0);
            }
#pragma unroll
            for (int k2 = 0; k2 < 32; ++k2) { u[2 * k2] = u2[k2].x; u[2 * k2 + 1] = u2[k2].y; }
        }
        LDSBAR();
        if (t < 128) {
            float* U = (float*)(ws + WS_CU) + (size_t)sid * 8192;
            const int dq = t >> 5, nt = (t >> 4) & 1, f = t & 15;
#pragma unroll
            for (int mt = 0; mt < 4; ++mt)
#pragma unroll
                for (int q4 = 0; q4 < 4; ++q4) { const f32x4 v = {u[16 * mt + 4 * q4], u[16 * mt + 4 * q4 + 1], u[16 * mt + 4 * q4 + 2], u[16 * mt + 4 * q4 + 3]};
                    *(f32x4*)(U + ((size_t)((dq * 8 + mt * 2 + nt) * 64 + q4 * 16 + f)) * 4) = v; }
        } else {
#pragma unroll
            for (int i = 0; i < 64; ++i) VT[i * 136 + (t - 128)] = (bf16)f2bf(u[i]);
        }
    }
    LDSBAR();
    {
        const float Glast = GB[63];
        bf16* Wb = (bf16*)(ws + WS_CW) + (size_t)sid * 8192; bf16* QD = (bf16*)(ws + WS_CQD) + (size_t)sid * 8192; bf16* KDT = (bf16*)(ws + WS_CKDT) + (size_t)sid * 8192;
#pragma unroll
        for (int k = 0; k < 4; ++k) { const int q = t + 256 * k, row = q >> 4, c8 = (q & 15) * 8;
            *(v4u*)(Wb + row * 128 + c8) = *(const LAS v4u*)(VT + row * 136 + c8);
            const v4u x = *(const LAS v4u*)(QT + row * 136 + c8); const float eg = __expf(GB[row]);
            v4u o; o.x = pk2(bflo(x.x) * eg, bfhi(x.x) * eg); o.y = pk2(bflo(x.y) * eg, bfhi(x.y) * eg); o.z = pk2(bflo(x.z) * eg, bfhi(x.z) * eg); o.w = pk2(bflo(x.w) * eg, bfhi(x.w) * eg);
            *(v4u*)(QD + row * 128 + c8) = o;
            const int dk = q >> 3, t8 = (q & 7) * 8; float kv[8];
#pragma unroll
            for (int e = 0; e < 8; ++e) kv[e] = bf2f(KT[(t8 + e) * 136 + dk]) * __expf(Glast - GB[t8 + e]);
            v4u ok; ok.x = pk2(kv[0], kv[1]); ok.y = pk2(kv[2], kv[3]); ok.z = pk2(kv[4], kv[5]); ok.w = pk2(kv[6], kv[7]);
            *(v4u*)(KDT + dk * 64 + t8) = ok; }
        if (t == 0) ((float*)(ws + WS_CDL))[sid] = __expf(Glast);
    }
    LDSBAR();
}

struct ScanRegs { v4u rw[2], rq[2], rk[2], ra; f32x4 ru; float rdl; };
template <int DRY> __device__ __forceinline__ void gdn_scan(const CPar& p, int l, int it, LAS unsigned char* lds, int tid) {
    const int n = it >> 5, h = (it >> 2) & 7, dq = it & 3, sid0 = (n * 8 + h) << 7;
    const int w = tid >> 6, lane = tid & 63, fr = lane & 15, fq = lane >> 4, mt = w >> 1, nt = w & 1;
    LAS bf16* Wt = (LAS bf16*)lds; LAS bf16* QDt = Wt + 64 * 136; LAS bf16* KDTt = QDt + 64 * 136; LAS bf16* At = KDTt + 128 * 72; LAS bf16* VNT = At + 64 * 72; LAS bf16* ST = VNT + 32 * 72;
    unsigned char* ws = lnd(p.ws);
    const bf16* Wb = (const bf16*)(ws + WS_CW); const bf16* QD = (const bf16*)(ws + WS_CQD); const bf16* KDT = (const bf16*)(ws + WS_CKDT); const bf16* ATT = (const bf16*)(ws + WS_CATT);
    const float* U = (const float*)(ws + WS_CU); const float* DL = (const float*)(ws + WS_CDL);
    float* O = (float*)(ws + WS_O) + ((size_t)n * SEQ + (tid >> 3)) * D + h * 128 + dq * 32 + (tid & 7) * 4;
    LAS float* OT = (LAS float*)(ST + 32 * 136);
    f32x4 S0 = {0.f, 0.f, 0.f, 0.f}, S1 = {0.f, 0.f, 0.f, 0.f};
    for (int q = tid; q < 32 * 136 / 2; q += NT) ((LAS unsigned*)ST)[q] = 0u;
    ScanRegs R0;
#define SC_LOAD(R, cc) do { const int cq_ = (cc) < 128 ? (cc) : 127; const size_t sb = (size_t)(sid0 + cq_); \
        _Pragma("unroll") for (int i2 = 0; i2 < 2; ++i2) { const int q = tid + 512 * i2; \
            R.rw[i2] = *(const v4u*)(Wb + sb * 8192 + (q >> 4) * 128 + (q & 15) * 8); R.rq[i2] = *(const v4u*)(QD + sb * 8192 + (q >> 4) * 128 + (q & 15) * 8); \
            R.rk[i2] = *(const v4u*)(KDT + sb * 8192 + (q >> 3) * 64 + (q & 7) * 8); } \
        R.ra = *(const v4u*)(ATT + sb * 4096 + (tid >> 3) * 64 + (tid & 7) * 8); \
        R.ru = *(const f32x4*)(U + sb * 8192 + (size_t)((dq * 8 + w) * 64 + lane) * 4); R.rdl = DL[sb]; } while (0)
#define SC_STORE(R) do { _Pragma("unroll") for (int i2 = 0; i2 < 2; ++i2) { const int q = tid + 512 * i2; \
            *(LAS v4u*)(Wt + (q >> 4) * 136 + (q & 15) * 8) = R.rw[i2]; *(LAS v4u*)(QDt + (q >> 4) * 136 + (q & 15) * 8) = R.rq[i2]; \
            *(LAS v4u*)(KDTt + (q >> 3) * 72 + (q & 7) * 8) = R.rk[i2]; } \
        *(LAS v4u*)(At + (tid >> 3) * 72 + (tid & 7) * 8) = R.ra; ucur = R.ru; dl = R.rdl; } while (0)
    f32x4 ucur; float dl;
    SC_LOAD(R0, 0);
    SC_STORE(R0);
    LDSBAR();
#define SC_STEP(cc, RL, RS, DRAIN, PH) do { \
        if (DRY < 2) SC_LOAD(RL, (cc) + 1); \
        f32x4 acc = {0.f, 0.f, 0.f, 0.f}, ao = {0.f, 0.f, 0.f, 0.f}; \
        bf16x8 sf_[4], wf_[4], qf_[4]; \
        _Pragma("unroll") for (int ks = 0; ks < 4; ++ks) { sf_[ks] = *(const LAS bf16x8*)(ST + (16 * nt + fr) * 136 + ks * 32 + fq * 8); wf_[ks] = *(const LAS bf16x8*)(Wt + (16 * mt + fr) * 136 + ks * 32 + fq * 8); } \
        _Pragma("unroll") for (int ks = 0; ks < 4; ++ks) qf_[ks] = *(const LAS bf16x8*)(QDt + (16 * mt + fr) * 136 + ks * 32 + fq * 8); \
        __builtin_amdgcn_sched_barrier(0);     \
        _Pragma("unroll") for (int ks = 0; ks < 4; ++ks) acc = MFMA16(wf_[ks], sf_[ks], acc); \
        _Pragma("unroll") for (int ks = 0; ks < 4; ++ks) ao = MFMA16(qf_[ks], sf_[ks], ao); \
        const f32x4 vn = ucur - acc; \
        { v2u o; o.x = pk2(vn[0], vn[1]); o.y = pk2(vn[2], vn[3]); *(LAS v2u*)(VNT + (16 * nt + fr) * 72 + 16 * mt + 4 * fq) = o; } \
        LDSBAR(); \
        S0 *= dl; S1 *= dl; \
        bf16x8 b0_[2], b1_[2], af_[2], kf_[2]; \
        _Pragma("unroll") for (int ks = 0; ks < 2; ++ks) { b0_[ks] = *(const LAS bf16x8*)(VNT + fr * 72 + ks * 32 + fq * 8); b1_[ks] = *(const LAS bf16x8*)(VNT + (16 + fr) * 72 + ks * 32 + fq * 8); \
            af_[ks] = *(const LAS bf16x8*)(At + (16 * mt + fr) * 72 + ks * 32 + fq * 8); kf_[ks] = *(const LAS bf16x8*)(KDTt + (16 * w + fr) * 72 + ks * 32 + fq * 8); } \
        __builtin_amdgcn_sched_barrier(0); \
        _Pragma("unroll") for (int ks = 0; ks < 2; ++ks) { S0 = MFMA16(kf_[ks], b0_[ks], S0); S1 = MFMA16(kf_[ks], b1_[ks], S1); ao = MFMA16(af_[ks], nt ? b1_[ks] : b0_[ks], ao); } \
        if (DRAIN) __builtin_amdgcn_s_waitcnt(0x0F70); \
        _Pragma("unroll") for (int e = 0; e < 4; ++e) OT[(PH) * 2304 + (16 * mt + 4 * fq + e) * 36 + 16 * nt + fr] = ao[e];     \
        LDSBAR(); \
        if (DRY == 0 && (PH) == 3) { _Pragma("unroll") for (int q_ = 0; q_ < 4; ++q_) *(f32x4*)(O + (size_t)((cc) - 3 + q_) * 64 * D) = *(const LAS f32x4*)(OT + q_ * 2304 + (tid >> 3) * 36 + (tid & 7) * 4); }     \
        { v2u o; o.x = pk2(S0[0], S0[1]); o.y = pk2(S0[2], S0[3]); *(LAS v2u*)(ST + fr * 136 + 16 * w + 4 * fq) = o; \
          o.x = pk2(S1[0], S1[1]); o.y = pk2(S1[2], S1[3]); *(LAS v2u*)(ST + (16 + fr) * 136 + 16 * w + 4 * fq) = o; } \
        if (DRY < 2) SC_STORE(RS); \
        LDSBAR(); } while (0)
#pragma unroll 1
    for (int c = 0; c < 128; c += 4) { SC_STEP(c, R0, R0, false, 0); SC_STEP(c + 1, R0, R0, false, 1); SC_STEP(c + 2, R0, R0, false, 2); SC_STEP(c + 3, R0, R0, false, 3); }
#undef SC_LOAD
#undef SC_STORE
#undef SC_STEP
    float* prec = lnd(p.out) + O_PREC + ((size_t)((l * 2 + n) * 8 + h)) * 16384;
    if (DRY == 0)
#pragma unroll
    for (int e = 0; e < 4; ++e) { prec[(size_t)(16 * w + 4 * fq + e) * 128 + dq * 32 + fr] = S0[e]; prec[(size_t)(16 * w + 4 * fq + e) * 128 + dq * 32 + 16 + fr] = S1[e]; }
    if (DRY) asm volatile("" :: "v"(S0), "v"(S1));
    LDSBAR();
}

__device__ __forceinline__ void gdn_decode(const CPar& p, int l, int it, LAS unsigned char* lds, int tid_) {
    const int tid = lnd_v(tid_);
    const int n = it >> 3, h = it & 7; const size_t m = (size_t)MPR + n;
    LAS float* qkv = (LAS float*)lds;
    LAS float* sc = qkv + 384;
    LAS float* PK = sc + 8;
    LAS float* PQ = PK + 2048;
    LAS float* VN = PQ + 2048;
    unsigned char* ws = lnd(p.ws);
    const bf16* qkvz = (const bf16*)(ws + WS_BIG); const float* BA = (const float*)(ws + WS_BA);
    const int w = tid >> 6, lane = tid & 63;
    if (tid < 384) {
        const int part = tid >> 7, d = tid & 127, col = part * 1024 + h * 128 + d;
        const float* cs = lnd(p.in[3]) + ((size_t)(l * NS + n) * 3) * 3072 + col; const float* cw = lnd(p.in[10]) + (size_t)l * 4 * 3072 + col;
        const float s0 = cs[0], s1 = cs[3072], s2 = cs[2 * 3072], xn = bf2f(qkvz[m * 4096 + col]);
        const float cv = cw[0] * s0 + cw[3072] * s1 + cw[2 * 3072] * s2 + cw[3 * 3072] * xn;
        qkv[tid] = silu_f(cv);
        float* so = lnd(p.out) + O_SCONV + ((size_t)(l * NS + n) * 3) * 3072 + col; so[0] = s1; so[3072] = s2; so[2 * 3072] = xn;
    }
    __syncthreads();
    if (w < 3) {
        const float a0 = (w == 1) ? qkv[128 + lane] : qkv[lane], a1 = (w == 1) ? qkv[192 + lane] : qkv[64 + lane];
        const float b0 = (w == 0) ? a0 : qkv[128 + lane], b1 = (w == 0) ? a1 : qkv[192 + lane];
        const float s = wave_sum(a0 * b0 + a1 * b1, lane);
        if (lane == 0) sc[w] = s;
    } else if (w == 3 && lane == 0) {
        const float braw = BA[m * 16 + h], araw = BA[m * 16 + 8 + h];
        const float xx = araw + lnd(p.in[12])[l * 8 + h]; const float sp = xx > 20.f ? xx : log1pf(expf(xx));
        sc[3] = 1.f / (1.f + expf(-braw)); sc[4] = expf(-expf(lnd(p.in[11])[l * 8 + h]) * sp);
    }
    __syncthreads();
    const float rq = rsqrtf(sc[0] + EPS) * 0.08838834764831845f, rk = rsqrtf(sc[1] + EPS), qk = sc[2] * rq * rk, beta = sc[3], eg = sc[4];
    const int dv4 = (tid & 31) * 4, grp = tid >> 5;
    const float* Sin = lnd(p.in[2]) + ((size_t)(l * NS + n) * 8 + h) * 16384;
    f32x4 S[8]; f32x4 pk = {0.f, 0.f, 0.f, 0.f}, pq = {0.f, 0.f, 0.f, 0.f};
#pragma unroll
    for (int i = 0; i < 8; ++i) { const int dk = grp * 8 + i; S[i] = *(const f32x4*)(Sin + (size_t)dk * 128 + dv4); pk += S[i] * (qkv[128 + dk] * rk); pq += S[i] * (qkv[dk] * rq); }
    *(LAS f32x4*)(PK + grp * 128 + dv4) = pk; *(LAS f32x4*)(PQ + grp * 128 + dv4) = pq;
    __syncthreads();
    if (tid < 128) {
        float ks = 0.f, qs = 0.f;
#pragma unroll
        for (int g = 0; g < 16; ++g) { ks += PK[g * 128 + tid]; qs += PQ[g * 128 + tid]; }
        const float vnew = beta * (qkv[256 + tid] - eg * ks);
        VN[tid] = vnew;
        ((float*)(ws + WS_O))[m * D + h * 128 + tid] = eg * qs + qk * vnew;
    }
    __syncthreads();
    float* So = lnd(p.out) + O_SREC + ((size_t)(l * NS + n) * 8 + h) * 16384;
    const f32x4 vn4 = *(const LAS f32x4*)(VN + dv4);
#pragma unroll
    for (int i = 0; i < 8; ++i) { const int dk = grp * 8 + i; *(f32x4*)(So + (size_t)dk * 128 + dv4) = S[i] * eg + vn4 * (qkv[128 + dk] * rk); }
    __syncthreads();
}

__device__ __forceinline__ void gdn_gate_rows(const CPar& p, int l, int gw, int NGW, int lane) {
    unsigned char* ws = lnd(p.ws);
    const float* O = (const float*)(ws + WS_O); const bf16* qkvz = (const bf16*)(ws + WS_BIG); bf16* OG = (bf16*)(ws + WS_OG);
    const float* gn = lnd(p.in[13]) + l * 128 + (lane & 7) * 16;
    f32x4 g4[4];
#pragma unroll
    for (int j = 0; j < 4; ++j) g4[j] = *(const f32x4*)(gn + 4 * j);
    f32x4 v[4]; v4u z0, z1;
    { const int mc = gw < MV ? gw : MV - 1; const f32x4* op = (const f32x4*)(O + (size_t)mc * D + lane * 16);
#pragma unroll
      for (int j = 0; j < 4; ++j) v[j] = op[j];
      const v4u* zp = (const v4u*)(qkvz + (size_t)mc * 4096 + 3072 + lane * 16); z0 = zp[0]; z1 = zp[1]; }
    for (int m = gw; m < MV; m += NGW) {
        f32x4 vn[4]; v4u zn0, zn1;
        { const int mc = (m + NGW < MV) ? m + NGW : MV - 1; const f32x4* op = (const f32x4*)(O + (size_t)mc * D + lane * 16);
#pragma unroll
          for (int j = 0; j < 4; ++j) vn[j] = op[j];
          const v4u* zp = (const v4u*)(qkvz + (size_t)mc * 4096 + 3072 + lane * 16); zn0 = zp[0]; zn1 = zp[1]; }
        float ss = 0.f;
#pragma unroll
        for (int j = 0; j < 4; ++j) ss += (v[j].x * v[j].x + v[j].y * v[j].y) + (v[j].z * v[j].z + v[j].w * v[j].w);
        ss += shx<1>(ss, lane); ss += shx<2>(ss, lane); ss += shx<4>(ss, lane);
        const float rstd = rsqrtf(ss * (1.f / 128.f) + EPS);
        const unsigned zz[8] = {z0.x, z0.y, z0.z, z0.w, z1.x, z1.y, z1.z, z1.w};
        unsigned ow[8];
#pragma unroll
        for (int j = 0; j < 4; ++j) {
            const float a0 = v[j].x * rstd * g4[j].x * silu_f(bflo(zz[2 * j])), a1 = v[j].y * rstd * g4[j].y * silu_f(bfhi(zz[2 * j]));
            const float a2 = v[j].z * rstd * g4[j].z * silu_f(bflo(zz[2 * j + 1])), a3 = v[j].w * rstd * g4[j].w * silu_f(bfhi(zz[2 * j + 1]));
            ow[2 * j] = pk2(a0, a1); ow[2 * j + 1] = pk2(a2, a3);
        }
        v4u* og = (v4u*)(OG + (size_t)m * D + lane * 16);
        og[0] = (v4u){ow[0], ow[1], ow[2], ow[3]}; og[1] = (v4u){ow[4], ow[5], ow[6], ow[7]};
#pragma unroll
        for (int j = 0; j < 4; ++j) v[j] = vn[j];
        z0 = zn0; z1 = zn1;
    }
    for (int e = gw * 64 + lane; e < 2 * 3 * 3072; e += NGW * 64) { const int n = e / 9216, r = e % 9216, j = r / 3072, col = r % 3072;
        lnd(p.out)[O_PCONV + (size_t)l * 18432 + e] = bf2f(qkvz[((size_t)n * SEQ + 8189 + j) * 4096 + col]); }
}

__device__ __forceinline__ void attn_prompt_item(const CPar& p, int item, LAS unsigned char* lds, int tid_) {
    const int tid = lnd_v(tid_);
    const int b = item >> 9, n = (item >> 8) & 1, g = (item >> 7) & 1, tile = item & 127;
    const int sh = 2 * b, seg = SEQ >> sh, P0 = tile * 64, segstart = P0 & ~(seg - 1), kp0 = P0 - 128;
    unsigned char* ws = lnd(p.ws);
    const bf16* Qb = (const bf16*)(ws + WS_QB); const bf16* Kb = (const bf16*)(ws + WS_KB); const bf16* Vb = (const bf16*)(ws + WS_VB);
    bf16* OB = (bf16*)(ws + WS_OB); float* LSE = (float*)(ws + WS_LSE);
    LAS bf16* Kt = (LAS bf16*)lds; LAS bf16* VTt = Kt + 192 * 72;
    const size_t kvbase = (size_t)((b * 2 + n) * 2 + g) * SEQ;
    bf16x8 bqa[2][2];
    { const int w_ = tid >> 6, l_ = tid & 63;
#pragma unroll
      for (int qt = 0; qt < 2; ++qt)
#pragma unroll
        for (int ks = 0; ks < 2; ++ks) bqa[qt][ks] = *(const bf16x8*)(Qb + ((size_t)((b * 2 + n) * 8 + g * 4 + (w_ >> 1)) * SEQ + P0 + (w_ & 1) * 32 + qt * 16 + (l_ & 15)) * 64 + ks * 32 + (l_ >> 4) * 8); }
#pragma unroll
    for (int i2 = 0; i2 < 3; ++i2) { const int q = tid + 512 * i2, row = q >> 3, c8 = (q & 7) * 8, pr = kp0 + row;
        v4u kx = {0u, 0u, 0u, 0u}, vx = {0u, 0u, 0u, 0u};
        if (pr >= segstart) { kx = *(const v4u*)(Kb + (kvbase + pr) * 64 + c8); vx = *(const v4u*)(Vb + (kvbase + pr) * 64 + c8); }
        *(LAS v4u*)(Kt + row * 72 + c8) = kx;
        VTt[(c8 + 0) * 204 + row] = (bf16)(vx.x & 0xffffu); VTt[(c8 + 1) * 204 + row] = (bf16)(vx.x >> 16);
        VTt[(c8 + 2) * 204 + row] = (bf16)(vx.y & 0xffffu); VTt[(c8 + 3) * 204 + row] = (bf16)(vx.y >> 16);
        VTt[(c8 + 4) * 204 + row] = (bf16)(vx.z & 0xffffu); VTt[(c8 + 5) * 204 + row] = (bf16)(vx.z >> 16);
        VTt[(c8 + 6) * 204 + row] = (bf16)(vx.w & 0xffffu); VTt[(c8 + 7) * 204 + row] = (bf16)(vx.w >> 16); }
    LDSBAR();
    const int w = tid >> 6, lane = tid & 63, fr = lane & 15, fq = lane >> 4;
    const int head = g * 4 + (w >> 1), qrow0 = (w & 1) * 32, kt0 = 2 * (w & 1);
    const float slope = exp2f(-(float)(head + 1)) * (float)(1 << sh);
#pragma unroll 1
    for (int qt = 0; qt < 2; ++qt) {
        bf16x8 bq[2];
        bq[0] = qt ? bqa[1][0] : bqa[0][0]; bq[1] = qt ? bqa[1][1] : bqa[0][1];
        const int fr2 = lnd_v(fr);
        f32x4 sc[10];
        const int qrel = qrow0 + qt * 16 + fr;
        const float c1 = 0.125f * 1.4426950408889634f, slope2 = slope * 1.4426950408889634f, tl = -slope2 * (float)(fr - 4 * fq);
        const bool fastseg = (kp0 >= segstart);
        float mx = -1e30f;
#pragma unroll
        for (int kt = 0; kt < 10; ++kt) {
            const int kk = kt - qt;
            if (kk < 0 || kk > 8) { sc[kt] = (f32x4){-1e30f, -1e30f, -1e30f, -1e30f}; }
            else {
                const bf16x8 a0 = *(const LAS bf16x8*)(Kt + ((kt0 + kt) * 16 + fr2) * 72 + fq * 8), a1 = *(const LAS bf16x8*)(Kt + ((kt0 + kt) * 16 + fr2) * 72 + 32 + fq * 8);
                f32x4 z = {0.f, 0.f, 0.f, 0.f}; z = MFMA16(a0, bq[0], z); z = MFMA16(a1, bq[1], z);
                if (fastseg && kk >= 1 && kk <= 7) {
                    const float cb = tl - slope2 * (float)(16 * (8 - kk));
#pragma unroll
                    for (int e = 0; e < 4; ++e) { const float sv = fmaf(z[e], c1, cb + slope2 * (float)e); z[e] = sv; mx = fmaxf(mx, sv); }
                } else {
#pragma unroll
                    for (int e = 0; e < 4; ++e) { const int keyrel = (kt0 + kt) * 16 + 4 * fq + e, dp = qrel + 128 - keyrel;
                        const bool valid = (dp >= 0) && (dp <= 128) && (kp0 + keyrel >= segstart);
                        const float sv = valid ? z[e] * c1 - slope2 * (float)dp : -1e30f; z[e] = sv; mx = fmaxf(mx, sv); }
                }
                sc[kt] = z;
            }
        }
        mx = fmaxf(mx, shx<16>(mx, lane)); mx = fmaxf(mx, shx<32>(mx, lane));
        float sm = 0.f;
#pragma unroll
        for (int kt = 0; kt < 10; ++kt)
#pragma unroll
            for (int e = 0; e < 4; ++e) { const float pe = __builtin_amdgcn_exp2f(sc[kt][e] - mx); sc[kt][e] = pe; sm += pe; }
        sm += shx<16>(sm, lane); sm += shx<32>(sm, lane);
        f32x4 oa[4];
#pragma unroll
        for (int dt = 0; dt < 4; ++dt) oa[dt] = (f32x4){0.f, 0.f, 0.f, 0.f};
#pragma unroll
        for (int s5 = 0; s5 < 5; ++s5) {
            const f32x4 plo = sc[2 * s5], phi = sc[2 * s5 + 1];
            v4u pw; pw.x = pk2(plo[0], plo[1]); pw.y = pk2(plo[2], plo[3]); pw.z = pk2(phi[0], phi[1]); pw.w = pk2(phi[2], phi[3]);
            const bf16x8 bp = __builtin_bit_cast(bf16x8, pw);
            const int kb = (kt0 + 2 * s5) * 16 + 4 * fq;
#pragma unroll
            for (int dt = 0; dt < 4; ++dt) { const v2u vlo = *(const LAS v2u*)(VTt + (dt * 16 + fr) * 204 + kb), vhi = *(const LAS v2u*)(VTt + (dt * 16 + fr) * 204 + kb + 16);
                const v4u vw = {vlo.x, vlo.y, vhi.x, vhi.y}; const bf16x8 av = __builtin_bit_cast(bf16x8, vw);
                oa[dt] = MFMA16(av, bp, oa[dt]); }
        }
        {
            const int pq = P0 + qrel, pl = pq & (seg - 1), res = pq >> (13 - sh), tok = (pl << sh) + res;
            const size_t m = (size_t)n * SEQ + tok; const float inv = 1.f / sm;
            bf16* op = OB + ((size_t)b * MV + m) * 512 + head * 64 + 4 * fq;
#pragma unroll
            for (int dt = 0; dt < 4; ++dt) { const f32x4 v = oa[dt] * inv; v2u o; o.x = pk2(v[0], v[1]); o.y = pk2(v[2], v[3]); *(v2u*)(op + dt * 16) = o; }
            if (fq == 0) LSE[((size_t)b * MV + m) * 8 + head] = mx * 0.6931471805599453f + __logf(sm);
        }
    }
    LDSBAR();
}
__device__ __forceinline__ void attn_decode_item(const CPar& p, int item, LAS unsigned char* lds, int tid_) {
    const int tid = lnd_v(tid_);
    const int n = item / 3, b = item % 3, sh = 2 * b, Wb = 128 << sh, dd = 1 << sh;
    unsigned char* ws = lnd(p.ws);
    const float* cache = lnd(p.in[4 + b]); const size_t os = (b == 0) ? O_SKV0 : (b == 1 ? O_SKV1 : O_SKV2);
    const float* newrow = lnd(p.out) + os + ((size_t)n * Wb + (Wb - 1)) * 256;
    LAS float* qf = (LAS float*)lds;
    LAS float* SC = qf + 512;
    LAS float* LS = SC + 8 * 132;
    { const bf16* Qs = (const bf16*)(ws + WS_QS) + (size_t)n * NQ + b * 512; qf[tid] = bf2f(Qs[tid]) * 0.125f; }
    __syncthreads();
#pragma unroll 1
    for (int pid = tid; pid < 129 * 8; pid += NT) { const int j = pid >> 3, hd = pid & 7, g = hd >> 2;
        const float* kp = (j == 0) ? newrow + g * 64 : cache + ((size_t)n * Wb + (Wb - j * dd)) * 256 + g * 64;
        float dot = 0.f;
#pragma unroll
        for (int q = 0; q < 16; ++q) { const f32x4 kv = *(const f32x4*)(kp + 4 * q); const f32x4 qv = *(const LAS f32x4*)(qf + hd * 64 + 4 * q); dot += (kv.x * qv.x + kv.y * qv.y) + (kv.z * qv.z + kv.w * qv.w); }
        SC[hd * 132 + j] = dot - exp2f(-(float)(hd + 1)) * (float)(j * dd); }
    __syncthreads();
    { const int hd = tid >> 6, lane = tid & 63;
      const float s0 = SC[hd * 132 + lane], s1 = SC[hd * 132 + 64 + lane], s2 = (lane == 0) ? SC[hd * 132 + 128] : -1e30f;
      float mx = fmaxf(fmaxf(s0, s1), s2);
      mx = wave_max(mx, lane);
      const float e0 = __expf(s0 - mx), e1 = __expf(s1 - mx), e2 = (lane == 0) ? __expf(s2 - mx) : 0.f;
      const float sum = wave_sum(e0 + e1 + e2, lane), inv = 1.f / sum;
      SC[hd * 132 + lane] = e0 * inv; SC[hd * 132 + 64 + lane] = e1 * inv; if (lane == 0) { SC[hd * 132 + 128] = e2 * inv; LS[hd] = mx + __logf(sum); } }
    __syncthreads();
    { const int hd = tid >> 6, dim = tid & 63, g = hd >> 2;
      float acc = SC[hd * 132] * newrow[128 + g * 64 + dim];
#pragma unroll 32
      for (int j = 1; j <= 128; ++j) acc += SC[hd * 132 + j] * cache[((size_t)n * Wb + (Wb - j * dd)) * 256 + 128 + g * 64 + dim];
      const size_t m = (size_t)MPR + n;
      ((bf16*)(ws + WS_OB))[((size_t)b * MV + m) * 512 + hd * 64 + dim] = (bf16)f2bf(acc);
      if (dim == 0) ((float*)(ws + WS_LSE))[((size_t)b * MV + m) * 8 + hd] = LS[hd]; }
    __syncthreads();
}
__device__ __forceinline__ void attn_merge_rows(const CPar& p, int gw, int NGW, int lane) {
    unsigned char* ws = lnd(p.ws);
    const bf16* OB = (const bf16*)(ws + WS_OB); const float* LSE = (const float*)(ws + WS_LSE); bf16* ATT = (bf16*)(ws + WS_ATT);
    const int head = lane >> 3;
    float l0, l1, l2; v4u a, bb, cc;
    { const int mc = gw < MV ? gw : MV - 1;
      l0 = LSE[((size_t)0 * MV + mc) * 8 + head]; l1 = LSE[((size_t)1 * MV + mc) * 8 + head]; l2 = LSE[((size_t)2 * MV + mc) * 8 + head];
      a = *(const v4u*)(OB + ((size_t)0 * MV + mc) * 512 + lane * 8); bb = *(const v4u*)(OB + ((size_t)1 * MV + mc) * 512 + lane * 8); cc = *(const v4u*)(OB + ((size_t)2 * MV + mc) * 512 + lane * 8); }
    for (int m = gw; m < MV; m += NGW) {
        const int mc = (m + NGW < MV) ? m + NGW : MV - 1;
        const float n0 = LSE[((size_t)0 * MV + mc) * 8 + head], n1 = LSE[((size_t)1 * MV + mc) * 8 + head], n2 = LSE[((size_t)2 * MV + mc) * 8 + head];
        const v4u na = *(const v4u*)(OB + ((size_t)0 * MV + mc) * 512 + lane * 8), nb = *(const v4u*)(OB + ((size_t)1 * MV + mc) * 512 + lane * 8), nc = *(const v4u*)(OB + ((size_t)2 * MV + mc) * 512 + lane * 8);
        const float mx = fmaxf(l0, fmaxf(l1, l2)); float w0 = __expf(l0 - mx), w1 = __expf(l1 - mx), w2 = __expf(l2 - mx); const float inv = 1.f / (w0 + w1 + w2);
        w0 *= inv; w1 *= inv; w2 *= inv;
        v4u o;
        o.x = pk2(w0 * bflo(a.x) + w1 * bflo(bb.x) + w2 * bflo(cc.x), w0 * bfhi(a.x) + w1 * bfhi(bb.x) + w2 * bfhi(cc.x));
        o.y = pk2(w0 * bflo(a.y) + w1 * bflo(bb.y) + w2 * bflo(cc.y), w0 * bfhi(a.y) + w1 * bfhi(bb.y) + w2 * bfhi(cc.y));
        o.z = pk2(w0 * bflo(a.z) + w1 * bflo(bb.z) + w2 * bflo(cc.z), w0 * bfhi(a.z) + w1 * bfhi(bb.z) + w2 * bfhi(cc.z));
        o.w = pk2(w0 * bflo(a.w) + w1 * bflo(bb.w) + w2 * bflo(cc.w), w0 * bfhi(a.w) + w1 * bfhi(bb.w) + w2 * bfhi(cc.w));
        *(v4u*)(ATT + (size_t)m * 512 + lane * 8) = o;
        l0 = n0; l1 = n1; l2 = n2; a = na; bb = nb; cc = nc;
    }
}
__device__ __forceinline__ void kv_shift_copy(const CPar& p, int wid, int nwk, int tid, int first) {
    for (int pc = wid; pc < NS * 21; pc += nwk) {
        if (first != 2 && ((pc % 5 < 2) != (first == 1))) continue;
        const int n = pc / 21, r = pc % 21, b = (r == 0) ? 0 : (r < 5 ? 1 : 2), piece = (b == 0) ? 0 : (b == 1 ? r - 1 : r - 5);
        const int Wb = 128 << (2 * b), row0 = piece * 128, nrow = (row0 + 128 <= Wb - 1) ? 128 : (Wb - 1 - row0);
        const size_t os = (b == 0) ? O_SKV0 : (b == 1 ? O_SKV1 : O_SKV2);
        const f32x4* src = (const f32x4*)lnd(p.in[4 + b]) + ((size_t)n * Wb + row0 + 1) * 64; f32x4* dst = (f32x4*)(lnd(p.out) + os) + ((size_t)n * Wb + row0) * 64;
        for (int f = tid; f < nrow * 64; f += NT) dst[f] = src[f];
    }
}

#define XB_TMO      128
#define XB_XCNT(j)  (256  + 64 * (j))
#define XB_XSUB(j)  (1280 + 64 * (j))
#define XB_XGEN(j)  (2304 + 64 * (j))
#define XB_TOP      3328
#define XB_TOPGEN   3392
#define XCD_BAR_WORDS 3456
#define XB_SPIN_CAP (1u << 18)

__device__ __forceinline__ unsigned xb_ld(unsigned* p)              { return __hip_atomic_load(p, __ATOMIC_RELAXED, __HIP_MEMORY_SCOPE_AGENT); }
__device__ __forceinline__ unsigned xb_add(unsigned* p, unsigned v) { return __hip_atomic_fetch_add(p, v, __ATOMIC_RELAXED, __HIP_MEMORY_SCOPE_AGENT); }
__device__ __forceinline__ unsigned xb_xcc_id() { return (unsigned)__builtin_amdgcn_s_getreg((3 << 11) | 20) & 0xFu; }
#define XB_SPIN(cond, bar) do { unsigned _sp = 0; while (cond) { __builtin_amdgcn_s_sleep(1); \
    if ((++_sp & 255u) == 0u) { if (xb_ld(&(bar)[XB_TMO])) break; if (_sp > XB_SPIN_CAP) { atomicAdd(&(bar)[XB_TMO], 1u); break; } } } } while (0)

struct XcdBarrier {
    unsigned* bar; unsigned x;
    volatile LAS unsigned* st;
};

__device__ __forceinline__ XcdBarrier xcd_barrier_post(unsigned* bar, volatile LAS unsigned* st) {
    XcdBarrier b; b.bar = bar; b.x = xb_xcc_id(); b.st = st;
    if (threadIdx.x == 0) (void)xb_add(&bar[XB_XCNT(b.x)], 1u);
    return b;
}
__device__ __forceinline__ void xcd_barrier_complete(unsigned* bar, unsigned x, unsigned& nloc, unsigned& nx) {
    const unsigned G = gridDim.x * gridDim.y * gridDim.z;
    unsigned sum, cnt, mine, sp = 0u;
    for (;;) {
        sum = 0u; cnt = 0u; mine = 0u;
#pragma unroll
        for (unsigned j = 0; j < 16; ++j) { const unsigned c = xb_ld(&bar[XB_XCNT(j)]); sum += c; cnt += (c > 0u) ? 1u : 0u; mine = (j == x) ? c : mine; }
        if (sum == G) break;
        __builtin_amdgcn_s_sleep(1);
        if ((++sp & 255u) == 0u) { if (xb_ld(&bar[XB_TMO])) break; if (sp > XB_SPIN_CAP) { atomicAdd(&bar[XB_TMO], 1u); break; } }
    }
    nloc = mine > 0u ? mine : 1u; nx = cnt > 0u ? cnt : 1u;
}

__device__ __forceinline__ void xcd_barrier(const XcdBarrier& b) {
    asm volatile("s_waitcnt vmcnt(0)" ::: "memory");
    __syncthreads();
    if (threadIdx.x == 0) {
        unsigned* bar = b.bar;
        __builtin_amdgcn_s_waitcnt(0);
        unsigned nloc = b.st[0], nx = b.st[1];
        if (nloc == 0u) { xcd_barrier_complete(bar, b.x, nloc, nx); b.st[0] = nloc; b.st[1] = nx; }
        const unsigned old = xb_add(&bar[XB_XSUB(b.x)], 1u);
        const unsigned gen = old / nloc;
        if (old + 1u == (gen + 1u) * nloc) {
            __builtin_amdgcn_fence(__ATOMIC_RELEASE, "agent");
            asm volatile("s_waitcnt vmcnt(0)" ::: "memory");
            const unsigned og = xb_add(&bar[XB_TOP], 1u);
            const unsigned tg = og / nx;
            if (og + 1u == (tg + 1u) * nx) xb_add(&bar[XB_TOPGEN], 1u);
            else XB_SPIN(xb_ld(&bar[XB_TOPGEN]) == tg, bar);
            __builtin_amdgcn_fence(__ATOMIC_ACQUIRE, "agent");
            xb_add(&bar[XB_XGEN(b.x)], 1u);
            asm volatile("s_waitcnt vmcnt(0)" ::: "memory");
        } else {
            XB_SPIN(xb_ld(&bar[XB_XGEN(b.x)]) == gen, bar);
            __builtin_amdgcn_fence(__ATOMIC_ACQUIRE, "agent");
            asm volatile("s_waitcnt vmcnt(0)" ::: "memory");
        }
    }
    __syncthreads();
}

constexpr int N_PHASES = 28;
__global__ void __launch_bounds__(NT, 2) yoco_fwd(Par p_in) {
    extern __shared__ __attribute__((aligned(16))) unsigned char lds_raw[];
    LAS unsigned char* lds = (LAS unsigned char*)lds_raw;
    cg::grid_group grid = cg::this_grid();
    const int lo = p_in.ph_lo, hi = p_in.ph_hi;
    const int wave0 = __builtin_amdgcn_readfirstlane((int)threadIdx.x >> 6);
    if (blockIdx.x == 0) for (int q = threadIdx.x; q < XCD_BAR_WORDS; q += NT) __hip_atomic_store((unsigned*)p_in.ws + q, 0u, __ATOMIC_RELAXED, __HIP_MEMORY_SCOPE_AGENT);
    volatile LAS unsigned* bst = (volatile LAS unsigned*)(lds + LDS_BYTES - 16);
    if (threadIdx.x < 4) bst[threadIdx.x] = 0u;
    __syncthreads();
    XcdBarrier xbar; xbar.bar = (unsigned*)p_in.ws; xbar.x = 0; xbar.st = bst;
    int nbar = 0;
#pragma unroll 1
    for (int it_ = 2 * lo; it_ < 2 * hi; ++it_) {
        const int ph = it_ >> 1;
        const CPar* kp_ = (const CPar*)__builtin_amdgcn_kernarg_segment_ptr(); asm volatile("" : "+s"(kp_)); const CPar& p = *kp_;
        const int wave = lnd_s(wave0), tid = lnd_v((wave << 6) | (int)__builtin_amdgcn_mbcnt_hi(~0u, __builtin_amdgcn_mbcnt_lo(~0u, 0u))), lane = tid & 63;
        const int G = lnd_s((int)gridDim.x), bid = lnd_s((int)blockIdx.x), gw = bid * NW + wave, NGW = G * NW;
        unsigned char* ws = lnd(p.ws);
        float* X = (float*)(ws + WS_X); bf16* XN = (bf16*)(ws + WS_XN); bf16* BIG = (bf16*)(ws + WS_BIG); float* SSb = (float*)(ws + WS_SS);
        int l, k;
        if (ph == 0) { l = 0; k = 0; }
        else if (ph < 15) { l = (ph - 1) / 7; const int j = (ph - 1) % 7; k = (j < 5) ? 1 + j : 2 + j; }
        else if (ph < 27) { l = 2 + (ph - 15) / 6; const int j = (ph - 15) % 6; k = (j < 4) ? 10 + j : 11 + j; }
        else { l = 3; k = 17; }
#ifndef PROBE_DUP
#define PROBE_DUP 0
#endif
#ifndef PROBE_DUPPH
#define PROBE_DUPPH 0ull
#endif
#ifndef PROBE_SYNC
#define PROBE_SYNC 0
#endif
        if ((it_ & 1) && !((PROBE_DUP >> k) & 1) && !((PROBE_DUPPH >> ph) & 1)) continue;
        {
        if (k == 0) { p0_weights(p, lds, gw, NGW, wave, lane, 0, (G > 64) ? P0_NA : P0_NITEMS); p0_prologue(p, lds, gw, NGW, wave, lane); }
        else if (k == 1) {
            pg8::Gemm g{XN, (const bf16*)(ws + WS_WIN) + (size_t)l * NPROJ_PAD * D, MPR, 4096, D}; pg8::StaticOrder S; S.init(MPR, 4096, G, bid);
            EpiProj E{BIG, SSb + (size_t)(2 * l) * MPR};
            pg8::gemm_phase<EpiProj, pg8::StaticOrder, true, true>(lds, g, S, E, tid);
            mini_items(p, 0, l, k, bid, G, tid, lds);
        } else if (k == 2) {
#ifndef NO_PREP
            for (int pi = bid; pi < 1024; pi += G) gdn_prep_pair(p, l, pi, lds, tid);
#endif
        } else if (k == 3) {
#ifndef NO_SCAN
            const int nscan = (G > 64) ? 64 : 0;
#ifndef PROBE_DRY
#define PROBE_DRY 0
#endif
            if (bid < nscan) { const int sit = (((bid & 7) * 2 + (bid >> 5)) << 2) | ((bid >> 3) & 3); if (PROBE_DRY) gdn_scan<PROBE_DRY>(p, l, sit, lds, tid); gdn_scan<0>(p, l, sit, lds, tid); }
            else {
                const int wid = bid - nscan, nwk = G - nscan;
                if (nscan == 0) for (int it = bid; it < 64; it += G) gdn_scan<0>(p, l, it, lds, tid);
                for (int it = wid; it < NS * 8; it += nwk) gdn_decode(p, l, it, lds, tid);
                if (l == 0 && nscan) { __syncthreads(); p0_weights(p, lds, wid * NW + wave, nwk * NW, wave, lane, P0_NA, P0_NITEMS); }
                kv_shift_copy(p, wid, nwk, tid, nscan ? (l == 0 ? 1 : 0) : 2);
            }
#endif
        } else if (k == 4) gdn_gate_rows(p, l, gw, NGW, lane);
        else if (k == 5 || k == 8 || k == 13 || k == 16) {
            const bf16* A; const bf16* Bt; int K;
            if (k == 5) { A = (const bf16*)(ws + WS_OG); Bt = (const bf16*)(ws + WS_WOUT) + (size_t)l * D * D; K = D; }
            else if (k == 13) { A = (const bf16*)(ws + WS_ATT); Bt = (const bf16*)(ws + WS_WO) + (size_t)(l - 2) * D * 512; K = 512; }
            else { A = BIG; Bt = (const bf16*)(ws + WS_WDN) + (size_t)l * D * FF; K = FF; }
            const int ssi = (k == 5 || k == 13) ? 2 * l + 1 : 2 * l + 2;
            pg8::Gemm g{A, Bt, MPR, D, K}; pg8::StaticOrder S; S.init(MPR, D, G, bid);
            EpiRes E{X, XN, SSb + (size_t)ssi * MPR, (k == 5 && l == 0) ? lnd(p.in[0]) : (const float*)X};
            pg8::gemm_phase<EpiRes, pg8::StaticOrder, true, true>(lds, g, S, E, tid);
            mini_items(p, 1, l, k, bid, G, tid, lds);
        } else if (k == 7 || k == 15) {
            pg8::Gemm g{XN, (const bf16*)(ws + WS_WUP) + (size_t)l * FF * D, MPR, FF, D}; pg8::StaticOrder S; S.init(MPR, FF, G, bid);
            EpiRelu2 E{BIG, FF, SSb + (size_t)(2 * l + 1) * MPR};
            pg8::gemm_phase<EpiRelu2, pg8::StaticOrder, true, true>(lds, g, S, E, tid);
            mini_items(p, 2, l, k, bid, G, tid, lds);
        } else if (k == 10) {
            const int Nn = (l == 2) ? NQKV2 : NQ;
            pg8::Gemm g{XN, (const bf16*)(ws + (l == 2 ? WS_WQKV2 : WS_WQ3)), MPR, Nn, D}; pg8::StaticOrder S; S.init(MPR, Nn, G, bid);
            EpiQKV E{(bf16*)(ws + WS_QB), (bf16*)(ws + WS_KB), (bf16*)(ws + WS_VB), lnd(p.out), SSb + (size_t)(2 * l) * MPR};
            pg8::gemm_phase<EpiQKV, pg8::StaticOrder, true, true>(lds, g, S, E, tid);
            mini_items(p, 3, l, k, bid, G, tid, lds);
        } else if (k == 11) {
#ifndef NO_ATTN
            for (int it = bid; it < 1536 + 384; it += G) { if (it < 1536) attn_prompt_item(p, it, lds, tid); else attn_decode_item(p, it - 1536, lds, tid); }
#endif
        } else if (k == 12) attn_merge_rows(p, gw, NGW, lane);
        else final_norm(X, lnd(p.in[21]), lnd(p.out), gw, NGW, lane);
        }
        if (it_ + 1 < 2 * hi) {
            if (nbar == 0) grid.sync();
            else xcd_barrier(xbar);
            if (nbar == 0) xbar = xcd_barrier_post((unsigned*)p_in.ws, bst);
            ++nbar;
            for (int e = 0; e < PROBE_SYNC; ++e) xcd_barrier(xbar);
        }
    }
}

extern "C" void kernel_launch(void* const* d_in, const int* in_sizes, int n_in, void* d_out, int out_size, void* d_ws, size_t ws_size, hipStream_t stream) {
    static int grid = 0;
    if (grid == 0) {
        if (n_in != 22 || (size_t)out_size != O_END || ws_size < WS_END) { fprintf(stderr, "kernel_launch: unexpected shapes (n_in %d, out %d, ws %zu)\n", n_in, out_size, ws_size); grid = -1; return; }
        int dev = 0, cus = 0, per_cu = 0;
        if (hipGetDevice(&dev) != hipSuccess || hipDeviceGetAttribute(&cus, hipDeviceAttributeMultiprocessorCount, dev) != hipSuccess) { grid = -1; return; }
        if (hipFuncSetAttribute((const void*)yoco_fwd, hipFuncAttributeMaxDynamicSharedMemorySize, LDS_BYTES) != hipSuccess) { fprintf(stderr, "kernel_launch: hipFuncSetAttribute failed\n"); grid = -1; return; }
        if (hipOccupancyMaxActiveBlocksPerMultiprocessor(&per_cu, (const void*)yoco_fwd, NT, LDS_BYTES) != hipSuccess || per_cu < 1) { fprintf(stderr, "kernel_launch: occupancy query says %d\n", per_cu); grid = -1; return; }
        grid = cus * per_cu;
    }
    if (grid < 0) return;
    Par a{};
    for (int i = 0; i < 22; ++i) a.in[i] = (const float*)d_in[i];
    a.out = (float*)d_out; a.ws = (unsigned char*)d_ws;
#if MK_MULTI
    for (int ph = 0; ph < N_PHASES; ++ph) { a.ph_lo = ph; a.ph_hi = ph + 1; hipLaunchKernelGGL(yoco_fwd, dim3(grid), dim3(NT), LDS_BYTES, stream, a); }
#else
    a.ph_lo = 0; a.ph_hi = N_PHASES;
    void* args[] = {&a};
    hipError_t e = hipLaunchCooperativeKernel((const void*)yoco_fwd, dim3(grid), dim3(NT), args, LDS_BYTES, stream);
    if (e != hipSuccess) fprintf(stderr, "kernel_launch: cooperative launch failed: %s (grid %d)\n", hipGetErrorString(e), grid);
#endif
}
```

```cpp
#include <hip/hip_runtime.h>
#include <hip/hip_cooperative_groups.h>
#include <cstdio>
#include <cstdint>
namespace cg = cooperative_groups;
__device__ __forceinline__ int lnd_v(int x) { asm volatile("" : "+v"(x)); return x; }
__device__ __forceinline__ int lnd_s(int x) { asm volatile("" : "+s"(x)); return x; }
namespace pg8 {
#define PG8_LAS __attribute__((address_space(3)))
typedef unsigned short bf16_t;
typedef short bf16x8 __attribute__((ext_vector_type(8)));
typedef float f32x4 __attribute__((ext_vector_type(4)));
typedef unsigned u32x4 __attribute__((ext_vector_type(4)));
constexpr int BM = 256, BK = 64, HALF = 128, HTB = HALF * BK * 2  , STAGE_BYTES = 8 * HTB, NXCD = 8, WGM = 8;

__host__ __device__ __forceinline__ int lds_byte(int r, int c) { const int st = (r >> 4) * 2 + (c >> 5), rr = r & 15, cc = c & 31, ob = rr * 64 + cc * 2; return st * 1024 + (ob ^ (((ob >> 9) & 1) << 5)); }
__host__ __device__ __forceinline__ void stage_rc(int b, int& R, int& C) { const int st = b / 1024, sb = b % 1024, swz = sb ^ (((sb >> 9) & 1) << 5); R = (st >> 1) * 16 + swz / 64; C = (st & 1) * 32 + (swz % 64) / 2; }
__host__ __device__ __forceinline__ int perm32(int rho) { const int n = rho >> 4, i = rho & 15; return 8 * (i >> 2) + 4 * n + (i & 3); }

struct Unit { int pm, pn; };
struct Gemm { const bf16_t* A; const bf16_t* Bt; int M, N, K; };

struct StaticOrder {
    int nM, nN, nwg, G, c;
    __host__ __device__ void init(int M, int N, int G_, int c_) { nM = M / BM; nN = N / BM; nwg = nM * nN; G = G_; c = c_; }
    __host__ __device__ bool next(int i, Unit& u) const {
        const long L = (long)i * G + c; if (L >= nwg) return false;
        int wgid = (int)L; { const int q = nwg / NXCD, r = nwg % NXCD, xcd = wgid % NXCD, off = wgid / NXCD; wgid = (xcd < r ? xcd * (q + 1) : r * (q + 1) + (xcd - r) * q) + off; }
        const int nig = WGM * nN, gid = wgid / nig, fm = gid * WGM, gsz = (nM - fm) < WGM ? (nM - fm) : WGM;
        u.pm = fm + ((wgid % nig) % gsz); u.pn = (wgid % nig) / gsz; return true;
    }
    __device__ __forceinline__ void a_ready(const Unit&) const {}
    __device__ __forceinline__ void done(const Unit&) const {}
};
__device__ __forceinline__ unsigned cvt_pk_bf16(float lo, float hi) { unsigned r; asm volatile("v_cvt_pk_bf16_f32 %0, %1, %2" : "=v"(r) : "v"(lo), "v"(hi)); return r; }
template <class Epi, class Sched, bool ALIGN_EPI = false, bool SP2 = false>
__device__ __forceinline__ void gemm_phase(PG8_LAS unsigned char* lds, const Gemm g, const Sched& S, const Epi& E, const int tid_in) {
    const int tid = tid_in, wid = __builtin_amdgcn_readfirstlane(tid >> 6), lane = tid & 63, wr = wid >> 2, wc = wid & 3, fr = lane & 15, fq = lane >> 4;
    const int K = g.K, nt = K / BK;
    unsigned voffA[2], voffB[2];
#pragma unroll
    for (int i = 0; i < 2; ++i) { int R, C; stage_rc(tid * 16 + i * 8192, R, C); const int Rb = Epi::PERM ? ((R & ~31) + perm32(R & 31)) : R;
        voffA[i] = (unsigned)(R * K + C) * 2u; voffB[i] = (unsigned)(Rb * K + C) * 2u; }
    const size_t kstep = (size_t)(BK * 2);
    const size_t hstep = (size_t)HALF * K * 2;
    const size_t tstep = 2 * hstep;
    const unsigned ldsw = (unsigned)wid * 1024u;
    const int aoff = lds_byte(wr * 64 + fr, fq * 8), boff = lds_byte(wc * 32 + fr, fq * 8);
#define PG8_SA(b, h) (((b) * 2 + (h)) * HTB)
#define PG8_SB(b, h) ((4 + (b) * 2 + (h)) * HTB)
#define PG8_STAGE(bufoff, gbase, voff) do { _Pragma("unroll") for (int _i = 0; _i < 2; ++_i) \
        __builtin_amdgcn_global_load_lds((const unsigned*)((const char*)(gbase) + (voff)[_i]), (PG8_LAS unsigned*)(lds + (bufoff) + ldsw + _i * 8192), 16, 0, 0); } while (0)
#define PG8_LDA(dst, b, h) do { _Pragma("unroll") for (int m = 0; m < 4; ++m) _Pragma("unroll") for (int k = 0; k < 2; ++k) dst[m][k] = *(const PG8_LAS bf16x8*)(lds + PG8_SA(b, h) + aoff + m * 2048 + k * 1024); } while (0)
#define PG8_LDB(dst, b, h) do { _Pragma("unroll") for (int n = 0; n < 2; ++n) _Pragma("unroll") for (int k = 0; k < 2; ++k) dst[n][k] = *(const PG8_LAS bf16x8*)(lds + PG8_SB(b, h) + boff + n * 2048 + k * 1024); } while (0)
#define PG8_MMA(ai, bj, At, Bt) do { __builtin_amdgcn_s_setprio(1); _Pragma("unroll") for (int m = 0; m < 4; ++m) _Pragma("unroll") for (int n = 0; n < 2; ++n) _Pragma("unroll") for (int k = 0; k < 2; ++k) \
        acc[ai][bj][m][n] = __builtin_amdgcn_mfma_f32_16x16x32_bf16(Bt[n][k], At[m][k], acc[ai][bj][m][n], 0, 0, 0); __builtin_amdgcn_s_setprio(0); } while (0)
#define PG8_WAIT_V(n) asm volatile("s_waitcnt vmcnt(" #n ")" ::: "memory")
#define PG8_WAIT_L(n) asm volatile("s_waitcnt lgkmcnt(" #n ")" ::: "memory")
#define PG8_BAR __builtin_amdgcn_s_barrier()
#define PG8_SCHED __builtin_amdgcn_sched_barrier(0)
    Unit cur, nxt; int ui = 0;
    if (!S.next(0, cur)) return;
    f32x4 acc[2][2][4][2];
#pragma unroll
    for (int a = 0; a < 2; ++a)
#pragma unroll
        for (int b = 0; b < 2; ++b)
#pragma unroll
            for (int m = 0; m < 4; ++m)
#pragma unroll
                for (int n = 0; n < 2; ++n) acc[a][b][m][n] = (f32x4){0.f, 0.f, 0.f, 0.f};
    bf16x8 At[4][2], B0[2][2], B1[2][2];
    const char* cA = (const char*)g.A + (size_t)cur.pm * tstep; const char* cB = (const char*)g.Bt + (size_t)cur.pn * tstep;
    S.a_ready(cur);
    if constexpr (SP2) {
        PG8_STAGE(PG8_SB(0, 0), cB, voffB); PG8_STAGE(PG8_SB(0, 1), cB + hstep, voffB); PG8_STAGE(PG8_SA(0, 0), cA, voffA); PG8_STAGE(PG8_SA(0, 1), cA + hstep, voffA);
        if (wr == 1) PG8_BAR;
        PG8_WAIT_V(2); PG8_BAR;
        PG8_STAGE(PG8_SB(1, 0), cB + kstep, voffB); PG8_STAGE(PG8_SA(1, 0), cA + kstep, voffA); PG8_STAGE(PG8_SB(1, 1), cB + hstep + kstep, voffB);
        PG8_WAIT_V(6); PG8_BAR;
    } else {
        PG8_STAGE(PG8_SB(0, 0), cB, voffB); PG8_STAGE(PG8_SA(0, 0), cA, voffA); PG8_STAGE(PG8_SB(0, 1), cB + hstep, voffB); PG8_STAGE(PG8_SA(0, 1), cA + hstep, voffA);
        if (wr == 1) PG8_BAR;
        PG8_WAIT_V(4); PG8_BAR;
        PG8_STAGE(PG8_SB(1, 0), cB + kstep, voffB); PG8_STAGE(PG8_SA(1, 0), cA + kstep, voffA); PG8_STAGE(PG8_SB(1, 1), cB + hstep + kstep, voffB);
        PG8_WAIT_V(6); PG8_BAR;
    }
    for (;;) {
        const bool has_next = S.next(ui + 1, nxt);
        const char* nA = has_next ? (const char*)g.A + (size_t)nxt.pm * tstep : cA; const char* nB = has_next ? (const char*)g.Bt + (size_t)nxt.pn * tstep : cB;
        for (int t = 0; t < nt; t += 2) {
            const bool last = (t == nt - 2);
            const char* a1 = cA + (size_t)(t + 1) * kstep;
            const char* a2 = last ? nA : cA + (size_t)(t + 2) * kstep; const char* b2 = last ? nB : cB + (size_t)(t + 2) * kstep;
            const char* a3 = a2 + kstep; const char* b3 = b2 + kstep;
            if (last && has_next) S.a_ready(nxt);
            if constexpr (SP2) {
            PG8_LDB(B0, 0, 0); PG8_LDB(B1, 0, 1); PG8_SCHED; PG8_LDA(At, 0, 0); PG8_STAGE(PG8_SA(1, 1), a1 + hstep, voffA);
            PG8_WAIT_V(8); PG8_WAIT_L(0); PG8_BAR; PG8_MMA(0, 0, At, B0); PG8_MMA(0, 1, At, B1); PG8_BAR; PG8_SCHED;
            PG8_LDA(At, 0, 1); PG8_STAGE(PG8_SB(0, 0), b2, voffB); PG8_STAGE(PG8_SB(0, 1), b2 + hstep, voffB); PG8_STAGE(PG8_SA(0, 0), a2, voffA);
            PG8_WAIT_V(8); PG8_WAIT_L(0); PG8_BAR; PG8_MMA(1, 0, At, B0); PG8_MMA(1, 1, At, B1); PG8_BAR; PG8_SCHED;
            PG8_LDB(B0, 1, 0); PG8_LDB(B1, 1, 1); PG8_SCHED; PG8_LDA(At, 1, 0); PG8_STAGE(PG8_SA(0, 1), a2 + hstep, voffA);
            PG8_WAIT_V(8); PG8_WAIT_L(0); PG8_BAR; PG8_MMA(0, 0, At, B0); PG8_MMA(0, 1, At, B1); PG8_BAR; PG8_SCHED;
            PG8_LDA(At, 1, 1); PG8_STAGE(PG8_SB(1, 0), b3, voffB); PG8_STAGE(PG8_SB(1, 1), b3 + hstep, voffB); PG8_STAGE(PG8_SA(1, 0), a3, voffA);
            PG8_WAIT_V(8); PG8_WAIT_L(0); PG8_BAR; PG8_MMA(1, 0, At, B0); PG8_MMA(1, 1, At, B1); PG8_BAR; PG8_SCHED;
            } else {
            PG8_LDB(B0, 0, 0); PG8_SCHED; PG8_LDA(At, 0, 0); PG8_STAGE(PG8_SA(1, 1), a1 + hstep, voffA);
            PG8_WAIT_L(8); PG8_BAR; PG8_WAIT_L(0); PG8_MMA(0, 0, At, B0); PG8_BAR; PG8_SCHED;
            PG8_LDB(B1, 0, 1); PG8_STAGE(PG8_SB(0, 0), b2, voffB);
            PG8_BAR; PG8_WAIT_L(0); PG8_MMA(0, 1, At, B1); PG8_BAR;
            PG8_LDA(At, 0, 1); PG8_STAGE(PG8_SA(0, 0), a2, voffA);
            PG8_BAR; PG8_WAIT_L(0); PG8_MMA(1, 0, At, B0); PG8_BAR; PG8_SCHED;
            PG8_STAGE(PG8_SB(0, 1), b2 + hstep, voffB);
            PG8_WAIT_V(6); PG8_BAR; PG8_MMA(1, 1, At, B1); PG8_BAR;
            PG8_LDB(B0, 1, 0); PG8_SCHED; PG8_LDA(At, 1, 0); PG8_STAGE(PG8_SA(0, 1), a2 + hstep, voffA);
            PG8_WAIT_L(8); PG8_BAR; PG8_WAIT_L(0); PG8_MMA(0, 0, At, B0); PG8_BAR; PG8_SCHED;
            PG8_LDB(B1, 1, 1); PG8_STAGE(PG8_SB(1, 0), b3, voffB);
            PG8_BAR; PG8_WAIT_L(0); PG8_MMA(0, 1, At, B1); PG8_BAR;
            PG8_LDA(At, 1, 1); PG8_STAGE(PG8_SA(1, 0), a3, voffA);
            PG8_BAR; PG8_WAIT_L(0); PG8_MMA(1, 0, At, B0); PG8_BAR; PG8_SCHED;
            PG8_STAGE(PG8_SB(1, 1), b3 + hstep, voffB);
            PG8_WAIT_V(6); PG8_BAR; PG8_MMA(1, 1, At, B1); PG8_BAR;
            }
        }
        if constexpr (ALIGN_EPI) { if (wr == 0) PG8_BAR; }
        if constexpr (!Epi::AFTER_DRAIN) { E(acc, cur, wr, wc, fr, fq); S.done(cur); }
        if (!has_next) break;
#pragma unroll
        for (int a = 0; a < 2; ++a)
#pragma unroll
            for (int b = 0; b < 2; ++b)
#pragma unroll
                for (int m = 0; m < 4; ++m)
#pragma unroll
                    for (int n = 0; n < 2; ++n) acc[a][b][m][n] = (f32x4){0.f, 0.f, 0.f, 0.f};
        cur = nxt; cA = nA; cB = nB; ++ui;
        if constexpr (ALIGN_EPI) { if (wr == 1) PG8_BAR; }
    }
    PG8_WAIT_V(0);
    if constexpr (!ALIGN_EPI) { if (wr == 0) PG8_BAR; }
    PG8_BAR;
    if constexpr (Epi::AFTER_DRAIN) { E.fused(acc, cur, wr, wc, fr, fq, lds, wid, lane); S.done(cur); }
#undef PG8_SA
#undef PG8_SB
#undef PG8_STAGE
#undef PG8_LDA
#undef PG8_LDB
#undef PG8_MMA
#undef PG8_WAIT_V
#undef PG8_WAIT_L
#undef PG8_BAR
#undef PG8_SCHED
}
}

#ifndef MK_MULTI
#define MK_MULTI 0
#endif

constexpr int NW = 8, NT = 512;
constexpr int D = 1024, FF = 4096, SEQ = 8192, MPR = 16384, NS = 128, MV = MPR + NS, MP = 16640;
constexpr int NPROJ = 4112, NPROJ_PAD = 4352, NQKV2 = 2304, NQ = 1536;
constexpr float EPS = 1e-6f;
constexpr size_t O_YP = 0, O_YS = 16777216, O_PREC = 16908288, O_PCONV = 17432576, O_PKV0 = 17469440, O_PKV1 = 17534976, O_PKV2 = 17797120,
                 O_SREC = 18845696, O_SCONV = 52400128, O_SKV0 = 54759424, O_SKV1 = 58953728, O_SKV2 = 75730944, O_END = 142839808;
constexpr size_t MiB = 1u << 20;
constexpr size_t WS_WIN = 1 * MiB, WS_WOUT = 19 * MiB, WS_WUP = 23 * MiB, WS_WDN = 55 * MiB, WS_WQKV2 = 87 * MiB, WS_WQ3 = 92 * MiB, WS_WO = 95 * MiB;
constexpr size_t WS_X = 98 * MiB, WS_XN = 164 * MiB, WS_BIG = 198 * MiB, WS_BA = 329 * MiB, WS_O = 331 * MiB, WS_OG = 397 * MiB;
constexpr size_t WS_CW = 430 * MiB, WS_CQD = 462 * MiB, WS_CKDT = 494 * MiB, WS_CATT = 526 * MiB, WS_CU = 542 * MiB, WS_CDL = 606 * MiB;
constexpr size_t WS_QB = 607 * MiB, WS_KB = 655 * MiB, WS_VB = 667 * MiB, WS_QS = 679 * MiB, WS_OB = 680 * MiB, WS_LSE = 729 * MiB, WS_ATT = 731 * MiB, WS_SS = 748 * MiB, WS_END = 749 * MiB;
constexpr int LDS_BYTES = 147456;

#define LAS __attribute__((address_space(3)))
typedef unsigned short bf16;
typedef unsigned v4u __attribute__((ext_vector_type(4)));
typedef unsigned v2u __attribute__((ext_vector_type(2)));
typedef float f32x4 __attribute__((ext_vector_type(4)));
typedef short bf16x8 __attribute__((ext_vector_type(8)));

typedef float f32x2_t __attribute__((ext_vector_type(2)));
typedef __bf16 bf16x2_t __attribute__((ext_vector_type(2)));
__device__ __forceinline__ unsigned pk2(float lo, float hi) { const f32x2_t v = {lo, hi}; const bf16x2_t r = __builtin_convertvector(v, bf16x2_t); return __builtin_bit_cast(unsigned, r); }
__device__ __forceinline__ unsigned f2bf(float f) { return pk2(f, 0.f) & 0xffffu; }
__device__ __forceinline__ float bflo(unsigned w) { return __builtin_bit_cast(float, w << 16); }
__device__ __forceinline__ float bfhi(unsigned w) { return __builtin_bit_cast(float, w & 0xffff0000u); }
__device__ __forceinline__ float bf2f(bf16 h) { return __builtin_bit_cast(float, (unsigned)h << 16); }
template <int M> __device__ __forceinline__ float shx(float v, int lane) {
    if constexpr (M < 32) return __builtin_bit_cast(float, __builtin_amdgcn_ds_swizzle(__builtin_bit_cast(int, v), (M << 10) | 0x1f));
    else return __builtin_bit_cast(float, __builtin_amdgcn_ds_bpermute((lane ^ 32) << 2, __builtin_bit_cast(int, v)));
}
__device__ __forceinline__ float wave_sum(float v, int lane) {
    v += shx<1>(v, lane); v += shx<2>(v, lane); v += shx<4>(v, lane); v += shx<8>(v, lane); v += shx<16>(v, lane); v += shx<32>(v, lane);
    return v;
}
__device__ __forceinline__ float wave_max(float v, int lane) {
    v = fmaxf(v, shx<1>(v, lane)); v = fmaxf(v, shx<2>(v, lane)); v = fmaxf(v, shx<4>(v, lane)); v = fmaxf(v, shx<8>(v, lane)); v = fmaxf(v, shx<16>(v, lane)); v = fmaxf(v, shx<32>(v, lane));
    return v;
}
__device__ __forceinline__ float silu_f(float x) { return x * __builtin_amdgcn_rcpf(1.f + __expf(-x)); }
#define LDSBAR() do { asm volatile("s_waitcnt lgkmcnt(0)" ::: "memory"); __builtin_amdgcn_s_barrier(); asm volatile("" ::: "memory"); } while (0)
#define MFMA16(a, b, c) __builtin_amdgcn_mfma_f32_16x16x32_bf16((a), (b), (c), 0, 0, 0)

template <class T> __device__ __forceinline__ T* lnd(T* q) { __attribute__((address_space(1))) T* g = (__attribute__((address_space(1))) T*)q; asm volatile("" : "+s"(g)); return (T*)g; }
struct Par { const float* in[22]; float* out; unsigned char* ws; int ph_lo, ph_hi; };
typedef __attribute__((address_space(4))) Par CPar;

__device__ __forceinline__ void epi_rstd(const float* ss, int row0, float (&r)[2][4]) {
#pragma unroll
    for (int ai = 0; ai < 2; ++ai)
#pragma unroll
        for (int m = 0; m < 4; ++m) r[ai][m] = rsqrtf(ss[row0 + ai * 128 + m * 16] * (1.f / D) + EPS);
}
struct EpiRelu2 {
    static constexpr bool PERM = true, AFTER_DRAIN = false;
    bf16* O; int ldc; const float* ss;
    __device__ __forceinline__ void operator()(const f32x4 (&acc)[2][2][4][2], const pg8::Unit& u, int wr, int wc, int fr, int fq) const {
        const int row0 = u.pm * 256 + wr * 64 + fr, col0 = u.pn * 256 + wc * 32 + 8 * fq;
        float rs[2][4]; epi_rstd(ss, row0, rs);
#pragma unroll
        for (int ai = 0; ai < 2; ++ai)
#pragma unroll
            for (int m = 0; m < 4; ++m) { bf16* rowp = O + (size_t)(row0 + ai * 128 + m * 16) * ldc + col0;
#pragma unroll
                for (int bj = 0; bj < 2; ++bj) { f32x4 v0 = acc[ai][bj][m][0] * rs[ai][m], v1 = acc[ai][bj][m][1] * rs[ai][m];
#pragma unroll
                    for (int e = 0; e < 4; ++e) { float a = fmaxf(v0[e], 0.f), b = fmaxf(v1[e], 0.f); v0[e] = a * a; v1[e] = b * b; }
                    v4u w; w.x = pk2(v0[0], v0[1]); w.y = pk2(v0[2], v0[3]); w.z = pk2(v1[0], v1[1]); w.w = pk2(v1[2], v1[3]);
                    *(v4u*)(rowp + bj * 128) = w; } }
    }
};
struct EpiRes {
    static constexpr bool PERM = true, AFTER_DRAIN = false;
    float* X; bf16* XB; float* ss; const float* Xsrc;
    __device__ __forceinline__ void operator()(const f32x4 (&acc)[2][2][4][2], const pg8::Unit& u, int wr, int wc, int fr, int fq) const {
        const int row0 = u.pm * 256 + wr * 64 + fr, col0 = u.pn * 256 + wc * 32 + 8 * fq, lane = fr + 16 * fq;
#pragma unroll
        for (int ai = 0; ai < 2; ++ai) {
            f32x4 xa[4][2][2];
#pragma unroll
            for (int m = 0; m < 4; ++m)
#pragma unroll
                for (int bj = 0; bj < 2; ++bj) { const f32x4* p0 = (const f32x4*)(Xsrc + (size_t)(row0 + ai * 128 + m * 16) * D + col0 + bj * 128); xa[m][bj][0] = p0[0]; xa[m][bj][1] = p0[1]; }
#pragma unroll
            for (int m = 0; m < 4; ++m) { const int row = row0 + ai * 128 + m * 16; float* rowp = X + (size_t)row * D + col0; bf16* xb = XB + (size_t)row * D + col0; float sq = 0.f;
#pragma unroll
                for (int bj = 0; bj < 2; ++bj) { f32x4* p0 = (f32x4*)(rowp + bj * 128); const f32x4 a = xa[m][bj][0] + acc[ai][bj][m][0], b = xa[m][bj][1] + acc[ai][bj][m][1]; p0[0] = a; p0[1] = b;
                    sq += (a[0] * a[0] + a[1] * a[1]) + (a[2] * a[2] + a[3] * a[3]) + (b[0] * b[0] + b[1] * b[1]) + (b[2] * b[2] + b[3] * b[3]);
                    v4u w; w.x = pk2(a[0], a[1]); w.y = pk2(a[2], a[3]); w.z = pk2(b[0], b[1]); w.w = pk2(b[2], b[3]);
                    *(v4u*)(xb + bj * 128) = w; }
                sq += shx<16>(sq, lane); sq += shx<32>(sq, lane);
                if (fq == 0) unsafeAtomicAdd(ss + row, sq); }
        }
    }
};
struct EpiProj {
    static constexpr bool PERM = true, AFTER_DRAIN = false;
    bf16* QKVZ; const float* ss;
    __device__ __forceinline__ void operator()(const f32x4 (&acc)[2][2][4][2], const pg8::Unit& u, int wr, int wc, int fr, int fq) const {
        const int row0 = u.pm * 256 + wr * 64 + fr, col0 = u.pn * 256 + wc * 32 + 8 * fq;
        float rs[2][4]; epi_rstd(ss, row0, rs);
#pragma unroll
        for (int ai = 0; ai < 2; ++ai)
#pragma unroll
            for (int m = 0; m < 4; ++m) { const int row = row0 + ai * 128 + m * 16;
#pragma unroll
                for (int bj = 0; bj < 2; ++bj) { const int c = col0 + bj * 128; const f32x4 v0 = acc[ai][bj][m][0] * rs[ai][m], v1 = acc[ai][bj][m][1] * rs[ai][m];
                    v4u w; w.x = pk2(v0[0], v0[1]); w.y = pk2(v0[2], v0[3]); w.z = pk2(v1[0], v1[1]); w.w = pk2(v1[2], v1[3]);
                    *(v4u*)(QKVZ + (size_t)row * 4096 + c) = w; } }
    }
};
struct EpiQKV {
    static constexpr bool PERM = true, AFTER_DRAIN = false;
    bf16 *Qb, *Kb, *Vb; float* out; const float* ss;
    __device__ __forceinline__ void operator()(const f32x4 (&acc)[2][2][4][2], const pg8::Unit& u, int wr, int wc, int fr, int fq) const {
        const int row0 = u.pm * 256 + wr * 64 + fr, col0 = u.pn * 256 + wc * 32 + 8 * fq;
        float rs[2][4]; epi_rstd(ss, row0, rs);
#pragma unroll
        for (int ai = 0; ai < 2; ++ai)
#pragma unroll
            for (int m = 0; m < 4; ++m) { const int row = row0 + ai * 128 + m * 16; const int n = row >> 13, i = row & 8191;
#pragma unroll
                for (int bj = 0; bj < 2; ++bj) { const int c = col0 + bj * 128; const f32x4 v0 = acc[ai][bj][m][0] * rs[ai][m], v1 = acc[ai][bj][m][1] * rs[ai][m];
                    v4u w; w.x = pk2(v0[0], v0[1]); w.y = pk2(v0[2], v0[3]); w.z = pk2(v1[0], v1[1]); w.w = pk2(v1[2], v1[3]);
                    if (c < NQ) {
                        const int b = c >> 9, head = (c >> 6) & 7, dim0 = c & 63, sh = 2 * b, pr = ((i & ((1 << sh) - 1)) << (13 - sh)) + (i >> sh);
                        *(v4u*)(Qb + ((size_t)(((b * 2 + n) * 8 + head) * 8192 + pr)) * 64 + dim0) = w;
                    } else {
                        const int cc = c - NQ, b = cc >> 8, kvsel = (cc >> 7) & 1, g = (cc >> 6) & 1, dim0 = cc & 63, Wb = 128 << (2 * b), sh = 2 * b, pr = ((i & ((1 << sh) - 1)) << (13 - sh)) + (i >> sh);
                        const size_t ob = (b == 0) ? O_PKV0 : (b == 1 ? O_PKV1 : O_PKV2);
                        bf16* dst = kvsel ? Vb : Kb;
                        *(v4u*)(dst + ((size_t)(((b * 2 + n) * 2 + g) * 8192 + pr)) * 64 + dim0) = w;
                        if (i >= SEQ - Wb) { f32x4* p0 = (f32x4*)(out + ob + ((size_t)n * Wb + (i - (SEQ - Wb))) * 256 + (cc & 255)); p0[0] = v0; p0[1] = v1; }
                    } } }
    }
};

template <bool AF32> __device__ __forceinline__ f32x4 mini_core(const void* A, int lda, int row, const bf16* Bt, int ldb, int brow, int k0, int klen, int fq, int lane, float& ssq) {
    f32x4 acc = {0.f, 0.f, 0.f, 0.f}; float sq = 0.f;
    const bf16* bp = Bt + (size_t)brow * ldb + k0 + fq * 8;
    if constexpr (AF32) {
        const float* ap = (const float*)A + (size_t)row * lda + k0 + fq * 8;
#pragma unroll 4
        for (int ks = 0; ks < klen / 32; ++ks) { const f32x4 x0 = *(const f32x4*)(ap + ks * 32), x1 = *(const f32x4*)(ap + ks * 32 + 4); const bf16x8 bf = *(const bf16x8*)(bp + ks * 32);
            sq += (x0[0] * x0[0] + x0[1] * x0[1]) + (x0[2] * x0[2] + x0[3] * x0[3]) + (x1[0] * x1[0] + x1[1] * x1[1]) + (x1[2] * x1[2] + x1[3] * x1[3]);
            v4u aw; aw.x = pk2(x0[0], x0[1]); aw.y = pk2(x0[2], x0[3]); aw.z = pk2(x1[0], x1[1]); aw.w = pk2(x1[2], x1[3]);
            acc = MFMA16(bf, __builtin_bit_cast(bf16x8, aw), acc); }
        sq += shx<16>(sq, lane); sq += shx<32>(sq, lane);
    } else {
        const bf16* ap = (const bf16*)A + (size_t)row * lda + k0 + fq * 8;
#pragma unroll 4
        for (int ks = 0; ks < klen / 32; ++ks) { const bf16x8 af = *(const bf16x8*)(ap + ks * 32); const bf16x8 bf = *(const bf16x8*)(bp + ks * 32); acc = MFMA16(bf, af, acc); }
    }
    ssq = sq; return acc;
}
__device__ __forceinline__ void mini_items(const CPar& p, int kind, int l, int k, int bid, int G, int tid, LAS unsigned char* lds) {
    unsigned char* ws = lnd(p.ws);
    const int w = tid >> 6, lane = tid & 63, fr = lane & 15, fq = lane >> 4;
    float* X = (float*)(ws + WS_X);
    if (kind == 0) {
        const bf16* Bt = (const bf16*)(ws + WS_WIN) + (size_t)l * NPROJ_PAD * D; bf16* QKVZ = (bf16*)(ws + WS_BIG); float* BA = (float*)(ws + WS_BA);
        for (int it = G - 1 - bid; it < 257 + 128; it += G) {
            float ssq;
            if (it < 257) { const int c0 = it * 16, r = 16 * w + fr;
                const f32x4 acc = mini_core<true>(X, D, MPR + r, Bt, D, c0 + fr, 0, D, fq, lane, ssq); const f32x4 v = acc * rsqrtf(ssq * (1.f / D) + EPS); const int col = c0 + 4 * fq;
                if (col < 4096) { v2u o; o.x = pk2(v[0], v[1]); o.y = pk2(v[2], v[3]); *(v2u*)(QKVZ + (size_t)(MPR + r) * 4096 + col) = o; }
                else *(f32x4*)(BA + (size_t)(MPR + r) * 16 + (col - 4096)) = v;
            } else { const int row = (it - 257) * 128 + 16 * w + fr;
                const f32x4 acc = mini_core<false>(ws + WS_XN, D, row, Bt, D, 4096 + fr, 0, D, fq, lane, ssq);
                const float rstd = rsqrtf(((const float*)(ws + WS_SS))[(size_t)(2 * l) * MPR + row] * (1.f / D) + EPS);
                *(f32x4*)(BA + (size_t)row * 16 + 4 * fq) = acc * rstd; }
        }
    } else if (kind == 1) {
        const bf16* A; const bf16* Bt; int K;
        if (k == 5) { A = (const bf16*)(ws + WS_OG); Bt = (const bf16*)(ws + WS_WOUT) + (size_t)l * D * D; K = D; }
        else if (k == 13) { A = (const bf16*)(ws + WS_ATT); Bt = (const bf16*)(ws + WS_WO) + (size_t)(l - 2) * D * 512; K = 512; }
        else { A = (const bf16*)(ws + WS_BIG); Bt = (const bf16*)(ws + WS_WDN) + (size_t)l * D * FF; K = FF; }
        LAS f32x4* red = (LAS f32x4*)lds;
        for (int it = G - 1 - bid; it < 256; it += G) { const int c0 = (it >> 2) * 16, r = (it & 3) * 32 + 16 * (w & 1) + fr, kq = w >> 1; float ssq;
            const f32x4 acc = mini_core<false>(A, K, MPR + r, Bt, K, c0 + fr, kq * (K / 4), K / 4, fq, lane, ssq);
            if (kq) red[((kq - 1) * 2 + (w & 1)) * 64 + lane] = acc;
            __syncthreads();
            if (!kq) { f32x4* xp = (f32x4*)(X + (size_t)(MPR + r) * D + c0 + 4 * fq); *xp = *xp + ((acc + red[(w & 1) * 64 + lane]) + (red[(2 + (w & 1)) * 64 + lane] + red[(4 + (w & 1)) * 64 + lane])); }
            __syncthreads(); }
    } else if (kind == 2) {
        const bf16* Bt = (const bf16*)(ws + WS_WUP) + (size_t)l * FF * D; bf16* H = (bf16*)(ws + WS_BIG);
        for (int it = G - 1 - bid; it < 256; it += G) { const int c0 = it * 16, r = 16 * w + fr; float ssq;
            const f32x4 acc = mini_core<true>(X, D, MPR + r, Bt, D, c0 + fr, 0, D, fq, lane, ssq); const f32x4 v = acc * rsqrtf(ssq * (1.f / D) + EPS);
            float t[4];
#pragma unroll
            for (int e = 0; e < 4; ++e) { const float a = fmaxf(v[e], 0.f); t[e] = a * a; }
            v2u o; o.x = pk2(t[0], t[1]); o.y = pk2(t[2], t[3]); *(v2u*)(H + (size_t)(MPR + r) * FF + c0 + 4 * fq) = o; }
    } else {
        const bf16* Bt = (const bf16*)(ws + (l == 2 ? WS_WQKV2 : WS_WQ3)); const int nch = (l == 2 ? NQKV2 : NQ) / 16; bf16* Qs = (bf16*)(ws + WS_QS); float* out = lnd(p.out);
        for (int it = G - 1 - bid; it < nch; it += G) { const int c0 = it * 16, r = 16 * w + fr; float ssq;
            const f32x4 acc = mini_core<true>(X, D, MPR + r, Bt, D, c0 + fr, 0, D, fq, lane, ssq); const f32x4 v = acc * rsqrtf(ssq * (1.f / D) + EPS); const int col = c0 + 4 * fq;
            if (col < NQ) { v2u o; o.x = pk2(v[0], v[1]); o.y = pk2(v[2], v[3]); *(v2u*)(Qs + (size_t)r * NQ + col) = o; }
            else { const int cc = col - NQ, b = cc >> 8, Wb = 128 << (2 * b); const size_t os = (b == 0) ? O_SKV0 : (b == 1 ? O_SKV1 : O_SKV2);
                *(f32x4*)(out + os + ((size_t)r * Wb + (Wb - 1)) * 256 + (cc & 255)) = v; } }
    }
}

__device__ __forceinline__ void p0_transpose_item(const float* W, int K, int Nsrc, int Npad, const float* gain, bf16* WT, int row_off, LAS float* scr, int item, int lane) {
    const int nblk = Npad / 64, kb = item / nblk, nb = item % nblk, k0 = 64 * kb, n0 = 64 * nb;
    const int nn = n0 + 4 * (lane & 15);
#pragma unroll 8
    for (int i = 0; i < 16; ++i) { const int kk = 4 * i + (lane >> 4); f32x4 v = {0.f, 0.f, 0.f, 0.f};
        if (nn < Nsrc) v = *(const f32x4*)(W + (size_t)(k0 + kk) * Nsrc + nn);
        if (gain) v = v * gain[k0 + kk];
        LAS float* d = scr + kk * 65 + 4 * (lane & 15); d[0] = v[0]; d[1] = v[1]; d[2] = v[2]; d[3] = v[3]; }
    asm volatile("s_waitcnt lgkmcnt(0)" ::: "memory");
    const int c = lane & 7;
#pragma unroll
    for (int j = 0; j < 8; ++j) { const int n = (lane >> 3) + 8 * j; const LAS float* sp = scr + (8 * c) * 65 + n;
        v4u o; o.x = pk2(sp[0 * 65], sp[1 * 65]); o.y = pk2(sp[2 * 65], sp[3 * 65]); o.z = pk2(sp[4 * 65], sp[5 * 65]); o.w = pk2(sp[6 * 65], sp[7 * 65]);
        *(v4u*)(WT + (size_t)(row_off + n0 + n) * K + k0 + 8 * c) = o; }
    asm volatile("s_waitcnt lgkmcnt(0)" ::: "memory");
}
constexpr int I_IN = (D / 64) * (NPROJ_PAD / 64), I_OUT = (D / 64) * (D / 64), I_UP = (D / 64) * (FF / 64), I_DN = (FF / 64) * (D / 64),
              I_Q = (D / 64) * (NQ / 64), I_KV = (D / 64) * (768 / 64), I_O = (512 / 64) * (D / 64);
constexpr int P0_NA = I_IN + I_OUT + I_UP + I_DN, P0_NITEMS = 2 * I_IN + 2 * I_OUT + 4 * I_UP + 4 * I_DN + 2 * I_Q + I_KV + 2 * I_O;
__device__ __forceinline__ void p0_weights(const CPar& p, LAS unsigned char* lds, int gw, int NGW, int wave, int lane, int first, int last) {
    LAS float* scr = (LAS float*)(lds + wave * 17408);
    unsigned char* ws = lnd(p.ws);
    for (int it = first + gw; it < last; it += NGW) {
        int r = it, type, l = 0;
        if (r < P0_NA) { if (r < I_IN) type = 0; else if ((r -= I_IN) < I_OUT) type = 1; else if ((r -= I_OUT) < I_UP) type = 2; else { r -= I_UP; type = 3; } }
        else { r -= P0_NA; l = 1;
            if (r < I_IN) type = 0; else if ((r -= I_IN) < I_OUT) type = 1;
            else if ((r -= I_OUT) < 3 * I_UP) { type = 2; l = 1 + r / I_UP; r %= I_UP; }
            else if ((r -= 3 * I_UP) < 3 * I_DN) { type = 3; l = 1 + r / I_DN; r %= I_DN; }
            else if ((r -= 3 * I_DN) < I_Q) type = 4; else if ((r -= I_Q) < I_KV) type = 5; else if ((r -= I_KV) < I_Q) type = 6; else { r -= I_Q; type = 7; l = r / I_O; r %= I_O; } }
        if (type == 0) p0_transpose_item(lnd(p.in[9]) + (size_t)l * D * NPROJ, D, NPROJ, NPROJ_PAD, lnd(p.in[7]) + l * D, (bf16*)(ws + WS_WIN) + (size_t)l * NPROJ_PAD * D, 0, scr, r, lane);
        else if (type == 1) p0_transpose_item(lnd(p.in[14]) + (size_t)l * D * D, D, D, D, nullptr, (bf16*)(ws + WS_WOUT) + (size_t)l * D * D, 0, scr, r, lane);
        else if (type == 2) p0_transpose_item(lnd(p.in[19]) + (size_t)l * D * FF, D, FF, FF, lnd(p.in[8]) + l * D, (bf16*)(ws + WS_WUP) + (size_t)l * FF * D, 0, scr, r, lane);
        else if (type == 3) p0_transpose_item(lnd(p.in[20]) + (size_t)l * FF * D, FF, D, D, nullptr, (bf16*)(ws + WS_WDN) + (size_t)l * D * FF, 0, scr, r, lane);
        else if (type == 4) p0_transpose_item(lnd(p.in[17]), D, NQ, NQ, lnd(p.in[7]) + 2 * D, (bf16*)(ws + WS_WQKV2), 0, scr, r, lane);
        else if (type == 5) p0_transpose_item(lnd(p.in[16]), D, 768, 768, lnd(p.in[15]), (bf16*)(ws + WS_WQKV2), NQ, scr, r, lane);
        else if (type == 6) p0_transpose_item(lnd(p.in[17]) + (size_t)D * NQ, D, NQ, NQ, lnd(p.in[7]) + 3 * D, (bf16*)(ws + WS_WQ3), 0, scr, r, lane);
        else p0_transpose_item(lnd(p.in[18]) + (size_t)l * 512 * D, 512, D, D, nullptr, (bf16*)(ws + WS_WO) + (size_t)l * D * 512, 0, scr, r, lane);
    }
}
__device__ __forceinline__ void p0_prologue(const CPar& p, LAS unsigned char* lds, int gw, int NGW, int wave, int lane) {
    unsigned char* ws = lnd(p.ws);
    float* X = (float*)(ws + WS_X); bf16* XN = (bf16*)(ws + WS_XN); float* SS = (float*)(ws + WS_SS);
    for (int m = gw; m < MV; m += NGW) {
        const float* src = (m < MPR) ? lnd(p.in[0]) + (size_t)m * D : lnd(p.in[1]) + (size_t)(m - MPR) * D;
        const f32x4* xr = (const f32x4*)src + lane; f32x4 v[4]; float s = 0.f;
#pragma unroll
        for (int j = 0; j < 4; ++j) { v[j] = xr[64 * j]; s += (v[j].x * v[j].x + v[j].y * v[j].y) + (v[j].z * v[j].z + v[j].w * v[j].w); }
        if (m >= MPR) { f32x4* xo = (f32x4*)(X + (size_t)m * D) + lane;
#pragma unroll
            for (int j = 0; j < 4; ++j) xo[64 * j] = v[j]; }
        if (m < MPR) { s = wave_sum(s, lane); v2u* o8 = (v2u*)(XN + (size_t)m * D) + lane;
#pragma unroll
            for (int j = 0; j < 4; ++j) { v2u o; o.x = pk2(v[j].x, v[j].y); o.y = pk2(v[j].z, v[j].w); o8[64 * j] = o; }
            if (lane == 0) SS[m] = s; }
    }
    for (int e = gw * 64 + lane; e < 8 * MPR; e += NGW * 64) __hip_atomic_store(SS + MPR + e, 0.f, __ATOMIC_RELAXED, __HIP_MEMORY_SCOPE_AGENT);
}
__device__ __forceinline__ void final_norm(const float* X, const float* gain, float* out, int gw, int NGW, int lane) {
    for (int m = gw; m < MV; m += NGW) {
        const f32x4* xr = (const f32x4*)(X + (size_t)m * D) + lane; f32x4 v[4]; float s = 0.f;
#pragma unroll
        for (int j = 0; j < 4; ++j) { v[j] = xr[64 * j]; s += (v[j].x * v[j].x + v[j].y * v[j].y) + (v[j].z * v[j].z + v[j].w * v[j].w); }
        const float rstd = rsqrtf(wave_sum(s, lane) * (1.f / D) + EPS);
        f32x4* o = (f32x4*)(out + (size_t)m * D) + lane; const f32x4* gp = (const f32x4*)gain + lane;
#pragma unroll
        for (int j = 0; j < 4; ++j) { const f32x4 g = gp[64 * j]; o[64 * j] = v[j] * rstd * g; }
    }
}

__device__ __forceinline__ void gdn_prep_pair(const CPar& p, int l, int pi, LAS unsigned char* lds, int tid_) {
    const int tid = lnd_v(tid_);
    const int sub = tid >> 8, t = tid & 255, wv = t >> 6, lane = t & 63, fr = lane & 15, fq = lane >> 4;
    const int item = 2 * pi + sub, n = item >> 10, c = (item >> 3) & 127, h = item & 7, sid = ((n * 8 + h) << 7) + c;
    LAS unsigned char* base = lds + sub * 70400;
    LAS bf16* QT = (LAS bf16*)base; LAS bf16* KT = QT + 64 * 136; LAS bf16* VT = KT + 64 * 136;
    LAS float* LM = (LAS float*)(base + 3 * 17408); LAS float* GB = LM + 64 * 68;
    unsigned char* ws = lnd(p.ws);
    const bf16* qkvz = (const bf16*)(ws + WS_BIG); const float* BA = (const float*)(ws + WS_BA);
    const float* cw = lnd(p.in[10]) + (size_t)l * 4 * 3072;
    float braw = 0.f, araw = 0.f;
    if (wv == 0) { const size_t m = (size_t)n * SEQ + c * 64 + lane; braw = BA[m * 16 + h]; araw = BA[m * 16 + 8 + h]; }
#pragma unroll 1
    for (int part = 0; part < 3; ++part) {
        const int col = part * 1024 + h * 128 + fr * 8;
        float w[4][8];
#pragma unroll
        for (int jj = 0; jj < 4; ++jj) { const f32x4 a = *(const f32x4*)(cw + jj * 3072 + col), b = *(const f32x4*)(cw + jj * 3072 + col + 4);
            w[jj][0] = a.x; w[jj][1] = a.y; w[jj][2] = a.z; w[jj][3] = a.w; w[jj][4] = b.x; w[jj][5] = b.y; w[jj][6] = b.z; w[jj][7] = b.w; }
        LAS bf16* tile = (part == 0) ? QT : (part == 1 ? KT : VT);
        v4u xx[4][4];
#pragma unroll
        for (int ps = 0; ps < 4; ++ps)
#pragma unroll
            for (int jj = 0; jj < 4; ++jj) { const int ii = c * 64 + ps * 16 + wv * 4 + fq - 3 + jj, iic = ii < 0 ? 0 : ii;
                xx[ps][jj] = *(const v4u*)(qkvz + ((size_t)n * SEQ + iic) * 4096 + col); }
#pragma unroll
        for (int ps = 0; ps < 4; ++ps) {
            const int r = ps * 16 + wv * 4 + fq, i = c * 64 + r;
            float a[8];
#pragma unroll
            for (int e = 0; e < 8; ++e) a[e] = 0.f;
#pragma unroll
            for (int jj = 0; jj < 4; ++jj) { const v4u x = xx[ps][jj]; const float gd = (i - 3 + jj >= 0) ? 1.f : 0.f;
                a[0] += gd * w[jj][0] * bflo(x.x); a[1] += gd * w[jj][1] * bfhi(x.x); a[2] += gd * w[jj][2] * bflo(x.y); a[3] += gd * w[jj][3] * bfhi(x.y);
                a[4] += gd * w[jj][4] * bflo(x.z); a[5] += gd * w[jj][5] * bfhi(x.z); a[6] += gd * w[jj][6] * bflo(x.w); a[7] += gd * w[jj][7] * bfhi(x.w); }
            float ss = 0.f;
#pragma unroll
            for (int e = 0; e < 8; ++e) { a[e] = silu_f(a[e]); ss += a[e] * a[e]; }
            if (part < 2) {
                ss += shx<1>(ss, lane); ss += shx<2>(ss, lane); ss += shx<4>(ss, lane); ss += shx<8>(ss, lane);
                const float sc = rsqrtf(ss + EPS) * (part == 0 ? 0.08838834764831845f : 1.f);
#pragma unroll
                for (int e = 0; e < 8; ++e) a[e] *= sc;
            }
            v4u o; o.x = pk2(a[0], a[1]); o.y = pk2(a[2], a[3]); o.z = pk2(a[4], a[5]); o.w = pk2(a[6], a[7]);
            *(LAS v4u*)(tile + r * 136 + fr * 8) = o;
        }
    }
    if (wv == 0) {
        const float beta = 1.f / (1.f + expf(-braw));
        const float xx = araw + lnd(p.in[12])[l * 8 + h]; const float sp = xx > 20.f ? xx : log1pf(expf(xx));
        float g = -expf(lnd(p.in[11])[l * 8 + h]) * sp;
#pragma unroll
        for (int o = 1; o < 64; o <<= 1) { const float y = __builtin_bit_cast(float, __builtin_amdgcn_ds_bpermute(((lane - o) & 63) << 2, __builtin_bit_cast(int, g))); if (lane >= o) g += y; }
        GB[lane] = g; GB[64 + lane] = beta;
    }
    LDSBAR();
    {
        bf16x8 bk[4], bq[4];
#pragma unroll
        for (int ks = 0; ks < 4; ++ks) { bk[ks] = *(const LAS bf16x8*)(KT + (16 * wv + fr) * 136 + ks * 32 + fq * 8); bq[ks] = *(const LAS bf16x8*)(QT + (16 * wv + fr) * 136 + ks * 32 + fq * 8); }
        const int i = 16 * wv + fr; const float Gi = GB[i], bi = GB[64 + i];
        bf16* attn = (bf16*)(ws + WS_CATT) + (size_t)sid * 4096;
#pragma unroll
        for (int jt = 0; jt < 4; ++jt) {
            f32x4 Lv = {0.f, 0.f, 0.f, 0.f}, Av = {0.f, 0.f, 0.f, 0.f};
            if (jt <= wv) {
                f32x4 akk = {0.f, 0.f, 0.f, 0.f}, aqk = {0.f, 0.f, 0.f, 0.f};
#pragma unroll
                for (int ks = 0; ks < 4; ++ks) { const bf16x8 a = *(const LAS bf16x8*)(KT + (16 * jt + fr) * 136 + ks * 32 + fq * 8); akk = MFMA16(a, bk[ks], akk); aqk = MFMA16(a, bq[ks], aqk); }
#pragma unroll
                for (int e = 0; e < 4; ++e) { const int j = 16 * jt + 4 * fq + e; const float dd = __expf(fminf(Gi - GB[j], 0.f));
                    Lv[e] = (i > j) ? bi * akk[e] * dd : 0.f; Av[e] = (i >= j) ? aqk[e] * dd : 0.f; }
            }
#pragma unroll
            for (int e = 0; e < 4; ++e) LM[(16 * jt + 4 * fq + e) * 68 + i] = Lv[e];
            v2u o; o.x = pk2(Av[0], Av[1]); o.y = pk2(Av[2], Av[3]);
            *(v2u*)(attn + i * 64 + 16 * jt + 4 * fq) = o;
        }
    }
    LDSBAR();
    {
        float u[64];
        if (t < 128) {
#pragma unroll
            for (int i = 0; i < 64; ++i) u[i] = bf2f(VT[i * 136 + t]) * GB[64 + i];
        } else {
#pragma unroll
            for (int i = 0; i < 64; ++i) u[i] = bf2f(KT[i * 136 + (t - 128)]) * GB[64 + i] * __expf(GB[i]);
        }
        {
            f32x2_t u2[32];
#pragma unroll
            for (int k2 = 0; k2 < 32; ++k2) u2[k2] = (f32x2_t){u[2 * k2], u[2 * k2 + 1]};
#pragma unroll
            for (int j = 0; j < 63; ++j) {
                const float ujs = (j & 1) ? u2[j >> 1].y : u2[j >> 1].x; const f32x2_t uj = {ujs, ujs};
#pragma unroll
                for (int i4 = (j + 1) / 4; i4 < 16; ++i4) { const f32x4 lv = *(const LAS f32x4*)(LM + j * 68 + 4 * i4);
                    u2[2 * i4] -= (f32x2_t){lv.x, lv.y} * uj; u2[2 * i4 + 1] -= (f32x2_t){lv.z, lv.w} * uj; }
                __builtin_amdgcn_sched_barrier(0);
            }
#pragma unroll
            for (int k2 = 0; k2 < 32; ++k2) { u[2 * k2] = u2[k2].x; u[2 * k2 + 1] = u2[k2].y; }
        }
        LDSBAR();
        if (t < 128) {
            float* U = (float*)(ws + WS_CU) + (size_t)sid * 8192;
            const int dq = t >> 5, nt = (t >> 4) & 1, f = t & 15;
#pragma unroll
            for (int mt = 0; mt < 4; ++mt)
#pragma unroll
                for (int q4 = 0; q4 < 4; ++q4) { const f32x4 v = {u[16 * mt + 4 * q4], u[16 * mt + 4 * q4 + 1], u[16 * mt + 4 * q4 + 2], u[16 * mt + 4 * q4 + 3]};
                    *(f32x4*)(U + ((size_t)((dq * 8 + mt * 2 + nt) * 64 + q4 * 16 + f)) * 4) = v; }
        } else {
#pragma unroll
            for (int i = 0; i < 64; ++i) VT[i * 136 + (t - 128)] = (bf16)f2bf(u[i]);
        }
    }
    LDSBAR();
    {
        const float Glast = GB[63];
        bf16* Wb = (bf16*)(ws + WS_CW) + (size_t)sid * 8192; bf16* QD = (bf16*)(ws + WS_CQD) + (size_t)sid * 8192; bf16* KDT = (bf16*)(ws + WS_CKDT) + (size_t)sid * 8192;
#pragma unroll
        for (int k = 0; k < 4; ++k) { const int q = t + 256 * k, row = q >> 4, c8 = (q & 15) * 8;
            *(v4u*)(Wb + row * 128 + c8) = *(const LAS v4u*)(VT + row * 136 + c8);
            const v4u x = *(const LAS v4u*)(QT + row * 136 + c8); const float eg = __expf(GB[row]);
            v4u o; o.x = pk2(bflo(x.x) * eg, bfhi(x.x) * eg); o.y = pk2(bflo(x.y) * eg, bfhi(x.y) * eg); o.z = pk2(bflo(x.z) * eg, bfhi(x.z) * eg); o.w = pk2(bflo(x.w) * eg, bfhi(x.w) * eg);
            *(v4u*)(QD + row * 128 + c8) = o;
            const int dk = q >> 3, t8 = (q & 7) * 8; float kv[8];
#pragma unroll
            for (int e = 0; e < 8; ++e) kv[e] = bf2f(KT[(t8 + e) * 136 + dk]) * __expf(Glast - GB[t8 + e]);
            v4u ok; ok.x = pk2(kv[0], kv[1]); ok.y = pk2(kv[2], kv[3]); ok.z = pk2(kv[4], kv[5]); ok.w = pk2(kv[6], kv[7]);
            *(v4u*)(KDT + dk * 64 + t8) = ok; }
        if (t == 0) ((float*)(ws + WS_CDL))[sid] = __expf(Glast);
    }
    LDSBAR();
}

struct ScanRegs { v4u rw[2], rq[2], rk[2], ra; f32x4 ru; float rdl; };
template <int DRY> __device__ __forceinline__ void gdn_scan(const CPar& p, int l, int it, LAS unsigned char* lds, int tid) {
    const int n = it >> 5, h = (it >> 2) & 7, dq = it & 3, sid0 = (n * 8 + h) << 7;
    const int w = tid >> 6, lane = tid & 63, fr = lane & 15, fq = lane >> 4, mt = w >> 1, nt = w & 1;
    LAS bf16* Wt = (LAS bf16*)lds; LAS bf16* QDt = Wt + 64 * 136; LAS bf16* KDTt = QDt + 64 * 136; LAS bf16* At = KDTt + 128 * 72; LAS bf16* VNT = At + 64 * 72; LAS bf16* ST = VNT + 32 * 72;
    unsigned char* ws = lnd(p.ws);
    const bf16* Wb = (const bf16*)(ws + WS_CW); const bf16* QD = (const bf16*)(ws + WS_CQD); const bf16* KDT = (const bf16*)(ws + WS_CKDT); const bf16* ATT = (const bf16*)(ws + WS_CATT);
    const float* U = (const float*)(ws + WS_CU); const float* DL = (const float*)(ws + WS_CDL);
    float* O = (float*)(ws + WS_O) + ((size_t)n * SEQ + (tid >> 3)) * D + h * 128 + dq * 32 + (tid & 7) * 4;
    LAS float* OT = (LAS float*)(ST + 32 * 136);
    f32x4 S0 = {0.f, 0.f, 0.f, 0.f}, S1 = {0.f, 0.f, 0.f, 0.f};
    for (int q = tid; q < 32 * 136 / 2; q += NT) ((LAS unsigned*)ST)[q] = 0u;
    ScanRegs R0;
#define SC_LOAD(R, cc) do { const int cq_ = (cc) < 128 ? (cc) : 127; const size_t sb = (size_t)(sid0 + cq_); \
        _Pragma("unroll") for (int i2 = 0; i2 < 2; ++i2) { const int q = tid + 512 * i2; \
            R.rw[i2] = *(const v4u*)(Wb + sb * 8192 + (q >> 4) * 128 + (q & 15) * 8); R.rq[i2] = *(const v4u*)(QD + sb * 8192 + (q >> 4) * 128 + (q & 15) * 8); \
            R.rk[i2] = *(const v4u*)(KDT + sb * 8192 + (q >> 3) * 64 + (q & 7) * 8); } \
        R.ra = *(const v4u*)(ATT + sb * 4096 + (tid >> 3) * 64 + (tid & 7) * 8); \
        R.ru = *(const f32x4*)(U + sb * 8192 + (size_t)((dq * 8 + w) * 64 + lane) * 4); R.rdl = DL[sb]; } while (0)
#define SC_STORE(R) do { _Pragma("unroll") for (int i2 = 0; i2 < 2; ++i2) { const int q = tid + 512 * i2; \
            *(LAS v4u*)(Wt + (q >> 4) * 136 + (q & 15) * 8) = R.rw[i2]; *(LAS v4u*)(QDt + (q >> 4) * 136 + (q & 15) * 8) = R.rq[i2]; \
            *(LAS v4u*)(KDTt + (q >> 3) * 72 + (q & 7) * 8) = R.rk[i2]; } \
        *(LAS v4u*)(At + (tid >> 3) * 72 + (tid & 7) * 8) = R.ra; ucur = R.ru; dl = R.rdl; } while (0)
    f32x4 ucur; float dl;
    SC_LOAD(R0, 0);
    SC_STORE(R0);
    LDSBAR();
#define SC_STEP(cc, RL, RS, DRAIN, PH) do { \
        if (DRY < 2) SC_LOAD(RL, (cc) + 1); \
        f32x4 acc = {0.f, 0.f, 0.f, 0.f}, ao = {0.f, 0.f, 0.f, 0.f}; \
        bf16x8 sf_[4], wf_[4], qf_[4]; \
        _Pragma("unroll") for (int ks = 0; ks < 4; ++ks) { sf_[ks] = *(const LAS bf16x8*)(ST + (16 * nt + fr) * 136 + ks * 32 + fq * 8); wf_[ks] = *(const LAS bf16x8*)(Wt + (16 * mt + fr) * 136 + ks * 32 + fq * 8); } \
        _Pragma("unroll") for (int ks = 0; ks < 4; ++ks) qf_[ks] = *(const LAS bf16x8*)(QDt + (16 * mt + fr) * 136 + ks * 32 + fq * 8); \
        __builtin_amdgcn_sched_barrier(0);     \
        _Pragma("unroll") for (int ks = 0; ks < 4; ++ks) acc = MFMA16(wf_[ks], sf_[ks], acc); \
        _Pragma("unroll") for (int ks = 0; ks < 4; ++ks) ao = MFMA16(qf_[ks], sf_[ks], ao); \
        const f32x4 vn = ucur - acc; \
        { v2u o; o.x = pk2(vn[0], vn[1]); o.y = pk2(vn[2], vn[3]); *(LAS v2u*)(VNT + (16 * nt + fr) * 72 + 16 * mt + 4 * fq) = o; } \
        LDSBAR(); \
        S0 *= dl; S1 *= dl; \
        bf16x8 b0_[2], b1_[2], af_[2], kf_[2]; \
        _Pragma("unroll") for (int ks = 0; ks < 2; ++ks) { b0_[ks] = *(const LAS bf16x8*)(VNT + fr * 72 + ks * 32 + fq * 8); b1_[ks] = *(const LAS bf16x8*)(VNT + (16 + fr) * 72 + ks * 32 + fq * 8); \
            af_[ks] = *(const LAS bf16x8*)(At + (16 * mt + fr) * 72 + ks * 32 + fq * 8); kf_[ks] = *(const LAS bf16x8*)(KDTt + (16 * w + fr) * 72 + ks * 32 + fq * 8); } \
        __builtin_amdgcn_sched_barrier(0); \
        _Pragma("unroll") for (int ks = 0; ks < 2; ++ks) { S0 = MFMA16(kf_[ks], b0_[ks], S0); S1 = MFMA16(kf_[ks], b1_[ks], S1); ao = MFMA16(af_[ks], nt ? b1_[ks] : b0_[ks], ao); } \
        if (DRAIN) __builtin_amdgcn_s_waitcnt(0x0F70); \
        _Pragma("unroll") for (int e = 0; e < 4; ++e) OT[(PH) * 2304 + (16 * mt + 4 * fq + e) * 36 + 16 * nt + fr] = ao[e];     \
        LDSBAR(); \
        if (DRY == 0 && (PH) == 3) { _Pragma("unroll") for (int q_ = 0; q_ < 4; ++q_) *(f32x4*)(O + (size_t)((cc) - 3 + q_) * 64 * D) = *(const LAS f32x4*)(OT + q_ * 2304 + (tid >> 3) * 36 + (tid & 7) * 4); }     \
        { v2u o; o.x = pk2(S0[0], S0[1]); o.y = pk2(S0[2], S0[3]); *(LAS v2u*)(ST + fr * 136 + 16 * w + 4 * fq) = o; \
          o.x = pk2(S1[0], S1[1]); o.y = pk2(S1[2], S1[3]); *(LAS v2u*)(ST + (16 + fr) * 136 + 16 * w + 4 * fq) = o; } \
        if (DRY < 2) SC_STORE(RS); \
        LDSBAR(); } while (0)
#pragma unroll 1
    for (int c = 0; c < 128; c += 4) { SC_STEP(c, R0, R0, false, 0); SC_STEP(c + 1, R0, R0, false, 1); SC_STEP(c + 2, R0, R0, false, 2); SC_STEP(c + 3, R0, R0, false, 3); }
#undef SC_LOAD
#undef SC_STORE
#undef SC_STEP
    float* prec = lnd(p.out) + O_PREC + ((size_t)((l * 2 + n) * 8 + h)) * 16384;
    if (DRY == 0)
#pragma unroll
    for (int e = 0; e < 4; ++e) { prec[(size_t)(16 * w + 4 * fq + e) * 128 + dq * 32 + fr] = S0[e]; prec[(size_t)(16 * w + 4 * fq + e) * 128 + dq * 32 + 16 + fr] = S1[e]; }
    if (DRY) asm volatile("" :: "v"(S0), "v"(S1));
    LDSBAR();
}

__device__ __forceinline__ void gdn_decode(const CPar& p, int l, int it, LAS unsigned char* lds, int tid_) {
    const int tid = lnd_v(tid_);
    const int n = it >> 3, h = it & 7; const size_t m = (size_t)MPR + n;
    LAS float* qkv = (LAS float*)lds;
    LAS float* sc = qkv + 384;
    LAS float* PK = sc + 8;
    LAS float* PQ = PK + 2048;
    LAS float* VN = PQ + 2048;
    unsigned char* ws = lnd(p.ws);
    const bf16* qkvz = (const bf16*)(ws + WS_BIG); const float* BA = (const float*)(ws + WS_BA);
    const int w = tid >> 6, lane = tid & 63;
    if (tid < 384) {
        const int part = tid >> 7, d = tid & 127, col = part * 1024 + h * 128 + d;
        const float* cs = lnd(p.in[3]) + ((size_t)(l * NS + n) * 3) * 3072 + col; const float* cw = lnd(p.in[10]) + (size_t)l * 4 * 3072 + col;
        const float s0 = cs[0], s1 = cs[3072], s2 = cs[2 * 3072], xn = bf2f(qkvz[m * 4096 + col]);
        const float cv = cw[0] * s0 + cw[3072] * s1 + cw[2 * 3072] * s2 + cw[3 * 3072] * xn;
        qkv[tid] = silu_f(cv);
        float* so = lnd(p.out) + O_SCONV + ((size_t)(l * NS + n) * 3) * 3072 + col; so[0] = s1; so[3072] = s2; so[2 * 3072] = xn;
    }
    __syncthreads();
    if (w < 3) {
        const float a0 = (w == 1) ? qkv[128 + lane] : qkv[lane], a1 = (w == 1) ? qkv[192 + lane] : qkv[64 + lane];
        const float b0 = (w == 0) ? a0 : qkv[128 + lane], b1 = (w == 0) ? a1 : qkv[192 + lane];
        const float s = wave_sum(a0 * b0 + a1 * b1, lane);
        if (lane == 0) sc[w] = s;
    } else if (w == 3 && lane == 0) {
        const float braw = BA[m * 16 + h], araw = BA[m * 16 + 8 + h];
        const float xx = araw + lnd(p.in[12])[l * 8 + h]; const float sp = xx > 20.f ? xx : log1pf(expf(xx));
        sc[3] = 1.f / (1.f + expf(-braw)); sc[4] = expf(-expf(lnd(p.in[11])[l * 8 + h]) * sp);
    }
    __syncthreads();
    const float rq = rsqrtf(sc[0] + EPS) * 0.08838834764831845f, rk = rsqrtf(sc[1] + EPS), qk = sc[2] * rq * rk, beta = sc[3], eg = sc[4];
    const int dv4 = (tid & 31) * 4, grp = tid >> 5;
    const float* Sin = lnd(p.in[2]) + ((size_t)(l * NS + n) * 8 + h) * 16384;
    f32x4 S[8]; f32x4 pk = {0.f, 0.f, 0.f, 0.f}, pq = {0.f, 0.f, 0.f, 0.f};
#pragma unroll
    for (int i = 0; i < 8; ++i) { const int dk = grp * 8 + i; S[i] = __builtin_nontemporal_load((const f32x4*)(Sin + (size_t)dk * 128 + dv4)); pk += S[i] * (qkv[128 + dk] * rk); pq += S[i] * (qkv[dk] * rq); }
    *(LAS f32x4*)(PK + grp * 128 + dv4) = pk; *(LAS f32x4*)(PQ + grp * 128 + dv4) = pq;
    __syncthreads();
    if (tid < 128) {
        float ks = 0.f, qs = 0.f;
#pragma unroll
        for (int g = 0; g < 16; ++g) { ks += PK[g * 128 + tid]; qs += PQ[g * 128 + tid]; }
        const float vnew = beta * (qkv[256 + tid] - eg * ks);
        VN[tid] = vnew;
        ((float*)(ws + WS_O))[m * D + h * 128 + tid] = eg * qs + qk * vnew;
    }
    __syncthreads();
    float* So = lnd(p.out) + O_SREC + ((size_t)(l * NS + n) * 8 + h) * 16384;
    const f32x4 vn4 = *(const LAS f32x4*)(VN + dv4);
#pragma unroll
    for (int i = 0; i < 8; ++i) { const int dk = grp * 8 + i; __builtin_nontemporal_store(S[i] * eg + vn4 * (qkv[128 + dk] * rk), (f32x4*)(So + (size_t)dk * 128 + dv4)); }
    __syncthreads();
}

__device__ __forceinline__ void gdn_gate_rows(const CPar& p, int l, int gw, int NGW, int lane) {
    unsigned char* ws = lnd(p.ws);
    const float* O = (const float*)(ws + WS_O); const bf16* qkvz = (const bf16*)(ws + WS_BIG); bf16* OG = (bf16*)(ws + WS_OG);
    const float* gn = lnd(p.in[13]) + l * 128 + (lane & 7) * 16;
    f32x4 g4[4];
#pragma unroll
    for (int j = 0; j < 4; ++j) g4[j] = *(const f32x4*)(gn + 4 * j);
    f32x4 v[4]; v4u z0, z1;
    { const int mc = gw < MV ? gw : MV - 1; const f32x4* op = (const f32x4*)(O + (size_t)mc * D + lane * 16);
#pragma unroll
      for (int j = 0; j < 4; ++j) v[j] = op[j];
      const v4u* zp = (const v4u*)(qkvz + (size_t)mc * 4096 + 3072 + lane * 16); z0 = zp[0]; z1 = zp[1]; }
    for (int m = gw; m < MV; m += NGW) {
        f32x4 vn[4]; v4u zn0, zn1;
        { const int mc = (m + NGW < MV) ? m + NGW : MV - 1; const f32x4* op = (const f32x4*)(O + (size_t)mc * D + lane * 16);
#pragma unroll
          for (int j = 0; j < 4; ++j) vn[j] = op[j];
          const v4u* zp = (const v4u*)(qkvz + (size_t)mc * 4096 + 3072 + lane * 16); zn0 = zp[0]; zn1 = zp[1]; }
        float ss = 0.f;
#pragma unroll
        for (int j = 0; j < 4; ++j) ss += (v[j].x * v[j].x + v[j].y * v[j].y) + (v[j].z * v[j].z + v[j].w * v[j].w);
        ss += shx<1>(ss, lane); ss += shx<2>(ss, lane); ss += shx<4>(ss, lane);
        const float rstd = rsqrtf(ss * (1.f / 128.f) + EPS);
        const unsigned zz[8] = {z0.x, z0.y, z0.z, z0.w, z1.x, z1.y, z1.z, z1.w};
        unsigned ow[8];
#pragma unroll
        for (int j = 0; j < 4; ++j) {
            const float a0 = v[j].x * rstd * g4[j].x * silu_f(bflo(zz[2 * j])), a1 = v[j].y * rstd * g4[j].y * silu_f(bfhi(zz[2 * j]));
            const float a2 = v[j].z * rstd * g4[j].z * silu_f(bflo(zz[2 * j + 1])), a3 = v[j].w * rstd * g4[j].w * silu_f(bfhi(zz[2 * j + 1]));
            ow[2 * j] = pk2(a0, a1); ow[2 * j + 1] = pk2(a2, a3);
        }
        v4u* og = (v4u*)(OG + (size_t)m * D + lane * 16);
        og[0] = (v4u){ow[0], ow[1], ow[2], ow[3]}; og[1] = (v4u){ow[4], ow[5], ow[6], ow[7]};
#pragma unroll
        for (int j = 0; j < 4; ++j) v[j] = vn[j];
        z0 = zn0; z1 = zn1;
    }
    for (int e = gw * 64 + lane; e < 2 * 3 * 3072; e += NGW * 64) { const int n = e / 9216, r = e % 9216, j = r / 3072, col = r % 3072;
        lnd(p.out)[O_PCONV + (size_t)l * 18432 + e] = bf2f(qkvz[((size_t)n * SEQ + 8189 + j) * 4096 + col]); }
}

__device__ __forceinline__ void attn_prompt_item(const CPar& p, int item, LAS unsigned char* lds, int tid_) {
    const int tid = lnd_v(tid_);
    const int b = item >> 9, n = (item >> 8) & 1, g = (item >> 7) & 1, tile = item & 127;
    const int sh = 2 * b, seg = SEQ >> sh, P0 = tile * 64, segstart = P0 & ~(seg - 1), kp0 = P0 - 128;
    unsigned char* ws = lnd(p.ws);
    const bf16* Qb = (const bf16*)(ws + WS_QB); const bf16* Kb = (const bf16*)(ws + WS_KB); const bf16* Vb = (const bf16*)(ws + WS_VB);
    bf16* OB = (bf16*)(ws + WS_OB); float* LSE = (float*)(ws + WS_LSE);
    LAS bf16* Kt = (LAS bf16*)lds; LAS bf16* VTt = Kt + 192 * 72;
    const size_t kvbase = (size_t)((b * 2 + n) * 2 + g) * SEQ;
    bf16x8 bqa[2][2];
    { const int w_ = tid >> 6, l_ = tid & 63;
#pragma unroll
      for (int qt = 0; qt < 2; ++qt)
#pragma unroll
        for (int ks = 0; ks < 2; ++ks) bqa[qt][ks] = *(const bf16x8*)(Qb + ((size_t)((b * 2 + n) * 8 + g * 4 + (w_ >> 1)) * SEQ + P0 + (w_ & 1) * 32 + qt * 16 + (l_ & 15)) * 64 + ks * 32 + (l_ >> 4) * 8); }
#pragma unroll
    for (int i2 = 0; i2 < 3; ++i2) { const int q = tid + 512 * i2, row = q >> 3, c8 = (q & 7) * 8, pr = kp0 + row;
        v4u kx = {0u, 0u, 0u, 0u}, vx = {0u, 0u, 0u, 0u};
        if (pr >= segstart) { kx = *(const v4u*)(Kb + (kvbase + pr) * 64 + c8); vx = *(const v4u*)(Vb + (kvbase + pr) * 64 + c8); }
        *(LAS v4u*)(Kt + row * 72 + c8) = kx;
        VTt[(c8 + 0) * 200 + row] = (bf16)(vx.x & 0xffffu); VTt[(c8 + 1) * 200 + row] = (bf16)(vx.x >> 16);
        VTt[(c8 + 2) * 200 + row] = (bf16)(vx.y & 0xffffu); VTt[(c8 + 3) * 200 + row] = (bf16)(vx.y >> 16);
        VTt[(c8 + 4) * 200 + row] = (bf16)(vx.z & 0xffffu); VTt[(c8 + 5) * 200 + row] = (bf16)(vx.z >> 16);
        VTt[(c8 + 6) * 200 + row] = (bf16)(vx.w & 0xffffu); VTt[(c8 + 7) * 200 + row] = (bf16)(vx.w >> 16); }
    LDSBAR();
    const int w = tid >> 6, lane = tid & 63, fr = lane & 15, fq = lane >> 4;
    const int head = g * 4 + (w >> 1), qrow0 = (w & 1) * 32, kt0 = 2 * (w & 1);
    const float slope = exp2f(-(float)(head + 1)) * (float)(1 << sh);
#pragma unroll 1
    for (int qt = 0; qt < 2; ++qt) {
        bf16x8 bq[2];
        bq[0] = qt ? bqa[1][0] : bqa[0][0]; bq[1] = qt ? bqa[1][1] : bqa[0][1];
        const int fr2 = lnd_v(fr);
        f32x4 sc[10];
        const int qrel = qrow0 + qt * 16 + fr;
        const float c1 = 0.125f * 1.4426950408889634f, slope2 = slope * 1.4426950408889634f, tl = -slope2 * (float)(fr - 4 * fq);
        const bool fastseg = (kp0 >= segstart);
        float mx = -1e30f;
#pragma unroll
        for (int kt = 0; kt < 10; ++kt) {
            const int kk = kt - qt;
            if (kk < 0 || kk > 8) { sc[kt] = (f32x4){-1e30f, -1e30f, -1e30f, -1e30f}; }
            else {
                const bf16x8 a0 = *(const LAS bf16x8*)(Kt + ((kt0 + kt) * 16 + fr2) * 72 + fq * 8), a1 = *(const LAS bf16x8*)(Kt + ((kt0 + kt) * 16 + fr2) * 72 + 32 + fq * 8);
                f32x4 z = {0.f, 0.f, 0.f, 0.f}; z = MFMA16(a0, bq[0], z); z = MFMA16(a1, bq[1], z);
                if (fastseg && kk >= 1 && kk <= 7) {
                    const float cb = tl - slope2 * (float)(16 * (8 - kk));
#pragma unroll
                    for (int e = 0; e < 4; ++e) { const float sv = fmaf(z[e], c1, cb + slope2 * (float)e); z[e] = sv; mx = fmaxf(mx, sv); }
                } else {
#pragma unroll
                    for (int e = 0; e < 4; ++e) { const int keyrel = (kt0 + kt) * 16 + 4 * fq + e, dp = qrel + 128 - keyrel;
                        const bool valid = (dp >= 0) && (dp <= 128) && (kp0 + keyrel >= segstart);
                        const float sv = valid ? z[e] * c1 - slope2 * (float)dp : -1e30f; z[e] = sv; mx = fmaxf(mx, sv); }
                }
                sc[kt] = z;
            }
        }
        mx = fmaxf(mx, shx<16>(mx, lane)); mx = fmaxf(mx, shx<32>(mx, lane));
        float sm = 0.f;
#pragma unroll
        for (int kt = 0; kt < 10; ++kt)
#pragma unroll
            for (int e = 0; e < 4; ++e) { const float pe = __builtin_amdgcn_exp2f(sc[kt][e] - mx); sc[kt][e] = pe; sm += pe; }
        sm += shx<16>(sm, lane); sm += shx<32>(sm, lane);
        f32x4 oa[4];
#pragma unroll
        for (int dt = 0; dt < 4; ++dt) oa[dt] = (f32x4){0.f, 0.f, 0.f, 0.f};
#pragma unroll
        for (int s5 = 0; s5 < 5; ++s5) {
            const f32x4 plo = sc[2 * s5], phi = sc[2 * s5 + 1];
            v4u pw; pw.x = pk2(plo[0], plo[1]); pw.y = pk2(plo[2], plo[3]); pw.z = pk2(phi[0], phi[1]); pw.w = pk2(phi[2], phi[3]);
            const bf16x8 bp = __builtin_bit_cast(bf16x8, pw);
            const int kb = (kt0 + 2 * s5) * 16 + 4 * fq;
#pragma unroll
            for (int dt = 0; dt < 4; ++dt) { const v2u vlo = *(const LAS v2u*)(VTt + (dt * 16 + fr) * 200 + kb), vhi = *(const LAS v2u*)(VTt + (dt * 16 + fr) * 200 + kb + 16);
                const v4u vw = {vlo.x, vlo.y, vhi.x, vhi.y}; const bf16x8 av = __builtin_bit_cast(bf16x8, vw);
                oa[dt] = MFMA16(av, bp, oa[dt]); }
        }
        {
            const int pq = P0 + qrel, pl = pq & (seg - 1), res = pq >> (13 - sh), tok = (pl << sh) + res;
            const size_t m = (size_t)n * SEQ + tok; const float inv = 1.f / sm;
            bf16* op = OB + ((size_t)b * MV + m) * 512 + head * 64 + 4 * fq;
#pragma unroll
            for (int dt = 0; dt < 4; ++dt) { const f32x4 v = oa[dt] * inv; v2u o; o.x = pk2(v[0], v[1]); o.y = pk2(v[2], v[3]); *(v2u*)(op + dt * 16) = o; }
            if (fq == 0) LSE[((size_t)b * MV + m) * 8 + head] = mx * 0.6931471805599453f + __logf(sm);
        }
    }
    LDSBAR();
}
__device__ __forceinline__ void attn_decode_item(const CPar& p, int item, LAS unsigned char* lds, int tid_) {
    const int tid = lnd_v(tid_);
    const int n = item / 3, b = item % 3, sh = 2 * b, Wb = 128 << sh, dd = 1 << sh;
    unsigned char* ws = lnd(p.ws);
    const float* cache = lnd(p.in[4 + b]); const size_t os = (b == 0) ? O_SKV0 : (b == 1 ? O_SKV1 : O_SKV2);
    const float* newrow = lnd(p.out) + os + ((size_t)n * Wb + (Wb - 1)) * 256;
    LAS float* qf = (LAS float*)lds;
    LAS float* SC = qf + 512;
    LAS float* LS = SC + 8 * 132;
    { const bf16* Qs = (const bf16*)(ws + WS_QS) + (size_t)n * NQ + b * 512; qf[tid] = bf2f(Qs[tid]) * 0.125f; }
    __syncthreads();
#pragma unroll 1
    for (int pid = tid; pid < 129 * 8; pid += NT) { const int j = pid >> 3, hd = pid & 7, g = hd >> 2;
        const float* kp = (j == 0) ? newrow + g * 64 : cache + ((size_t)n * Wb + (Wb - j * dd)) * 256 + g * 64;
        float dot = 0.f;
#pragma unroll
        for (int q = 0; q < 16; ++q) { const f32x4 kv = *(const f32x4*)(kp + 4 * q); const f32x4 qv = *(const LAS f32x4*)(qf + hd * 64 + 4 * q); dot += (kv.x * qv.x + kv.y * qv.y) + (kv.z * qv.z + kv.w * qv.w); }
        SC[hd * 132 + j] = dot - exp2f(-(float)(hd + 1)) * (float)(j * dd); }
    __syncthreads();
    { const int hd = tid >> 6, lane = tid & 63;
      const float s0 = SC[hd * 132 + lane], s1 = SC[hd * 132 + 64 + lane], s2 = (lane == 0) ? SC[hd * 132 + 128] : -1e30f;
      float mx = fmaxf(fmaxf(s0, s1), s2);
      mx = wave_max(mx, lane);
      const float e0 = __expf(s0 - mx), e1 = __expf(s1 - mx), e2 = (lane == 0) ? __expf(s2 - mx) : 0.f;
      const float sum = wave_sum(e0 + e1 + e2, lane), inv = 1.f / sum;
      SC[hd * 132 + lane] = e0 * inv; SC[hd * 132 + 64 + lane] = e1 * inv; if (lane == 0) { SC[hd * 132 + 128] = e2 * inv; LS[hd] = mx + __logf(sum); } }
    __syncthreads();
    { const int hd = tid >> 6, dim = tid & 63, g = hd >> 2;
      float acc = SC[hd * 132] * newrow[128 + g * 64 + dim];
#pragma unroll 32
      for (int j = 1; j <= 128; ++j) acc += SC[hd * 132 + j] * cache[((size_t)n * Wb + (Wb - j * dd)) * 256 + 128 + g * 64 + dim];
      const size_t m = (size_t)MPR + n;
      ((bf16*)(ws + WS_OB))[((size_t)b * MV + m) * 512 + hd * 64 + dim] = (bf16)f2bf(acc);
      if (dim == 0) ((float*)(ws + WS_LSE))[((size_t)b * MV + m) * 8 + hd] = LS[hd]; }
    __syncthreads();
}
__device__ __forceinline__ void attn_merge_rows(const CPar& p, int gw, int NGW, int lane) {
    unsigned char* ws = lnd(p.ws);
    const bf16* OB = (const bf16*)(ws + WS_OB); const float* LSE = (const float*)(ws + WS_LSE); bf16* ATT = (bf16*)(ws + WS_ATT);
    const int head = lane >> 3;
    float l0, l1, l2; v4u a, bb, cc;
    { const int mc = gw < MV ? gw : MV - 1;
      l0 = LSE[((size_t)0 * MV + mc) * 8 + head]; l1 = LSE[((size_t)1 * MV + mc) * 8 + head]; l2 = LSE[((size_t)2 * MV + mc) * 8 + head];
      a = *(const v4u*)(OB + ((size_t)0 * MV + mc) * 512 + lane * 8); bb = *(const v4u*)(OB + ((size_t)1 * MV + mc) * 512 + lane * 8); cc = *(const v4u*)(OB + ((size_t)2 * MV + mc) * 512 + lane * 8); }
    for (int m = gw; m < MV; m += NGW) {
        const int mc = (m + NGW < MV) ? m + NGW : MV - 1;
        const float n0 = LSE[((size_t)0 * MV + mc) * 8 + head], n1 = LSE[((size_t)1 * MV + mc) * 8 + head], n2 = LSE[((size_t)2 * MV + mc) * 8 + head];
        const v4u na = *(const v4u*)(OB + ((size_t)0 * MV + mc) * 512 + lane * 8), nb = *(const v4u*)(OB + ((size_t)1 * MV + mc) * 512 + lane * 8), nc = *(const v4u*)(OB + ((size_t)2 * MV + mc) * 512 + lane * 8);
        const float mx = fmaxf(l0, fmaxf(l1, l2)); float w0 = __expf(l0 - mx), w1 = __expf(l1 - mx), w2 = __expf(l2 - mx); const float inv = 1.f / (w0 + w1 + w2);
        w0 *= inv; w1 *= inv; w2 *= inv;
        v4u o;
        o.x = pk2(w0 * bflo(a.x) + w1 * bflo(bb.x) + w2 * bflo(cc.x), w0 * bfhi(a.x) + w1 * bfhi(bb.x) + w2 * bfhi(cc.x));
        o.y = pk2(w0 * bflo(a.y) + w1 * bflo(bb.y) + w2 * bflo(cc.y), w0 * bfhi(a.y) + w1 * bfhi(bb.y) + w2 * bfhi(cc.y));
        o.z = pk2(w0 * bflo(a.z) + w1 * bflo(bb.z) + w2 * bflo(cc.z), w0 * bfhi(a.z) + w1 * bfhi(bb.z) + w2 * bfhi(cc.z));
        o.w = pk2(w0 * bflo(a.w) + w1 * bflo(bb.w) + w2 * bflo(cc.w), w0 * bfhi(a.w) + w1 * bfhi(bb.w) + w2 * bfhi(cc.w));
        *(v4u*)(ATT + (size_t)m * 512 + lane * 8) = o;
        l0 = n0; l1 = n1; l2 = n2; a = na; bb = nb; cc = nc;
    }
}
__device__ __forceinline__ void kv_shift_copy(const CPar& p, int wid, int nwk, int tid, int first) {
    for (int pc = wid; pc < NS * 21; pc += nwk) {
        if (first != 2 && ((pc % 5 < 2) != (first == 1))) continue;
        const int n = pc / 21, r = pc % 21, b = (r == 0) ? 0 : (r < 5 ? 1 : 2), piece = (b == 0) ? 0 : (b == 1 ? r - 1 : r - 5);
        const int Wb = 128 << (2 * b), row0 = piece * 128, nrow = (row0 + 128 <= Wb - 1) ? 128 : (Wb - 1 - row0);
        const size_t os = (b == 0) ? O_SKV0 : (b == 1 ? O_SKV1 : O_SKV2);
        const f32x4* src = (const f32x4*)lnd(p.in[4 + b]) + ((size_t)n * Wb + row0 + 1) * 64; f32x4* dst = (f32x4*)(lnd(p.out) + os) + ((size_t)n * Wb + row0) * 64;
        for (int f = tid; f < nrow * 64; f += NT) __builtin_nontemporal_store(__builtin_nontemporal_load(src + f), dst + f);
    }
}

#define XB_TMO      128
#define XB_XCNT(j)  (256  + 64 * (j))
#define XB_XSUB(j)  (1280 + 64 * (j))
#define XB_XGEN(j)  (2304 + 64 * (j))
#define XB_TOP      3328
#define XB_TOPGEN   3392
#define XCD_BAR_WORDS 3456
#define XB_SPIN_CAP (1u << 18)

__device__ __forceinline__ unsigned xb_ld(unsigned* p)              { return __hip_atomic_load(p, __ATOMIC_RELAXED, __HIP_MEMORY_SCOPE_AGENT); }
__device__ __forceinline__ unsigned xb_add(unsigned* p, unsigned v) { return __hip_atomic_fetch_add(p, v, __ATOMIC_RELAXED, __HIP_MEMORY_SCOPE_AGENT); }
__device__ __forceinline__ unsigned xb_xcc_id() { return (unsigned)__builtin_amdgcn_s_getreg((3 << 11) | 20) & 0xFu; }
#define XB_SPIN(cond, bar) do { unsigned _sp = 0; while (cond) { __builtin_amdgcn_s_sleep(1); \
    if ((++_sp & 255u) == 0u) { if (xb_ld(&(bar)[XB_TMO])) break; if (_sp > XB_SPIN_CAP) { atomicAdd(&(bar)[XB_TMO], 1u); break; } } } } while (0)

struct XcdBarrier {
    unsigned* bar; unsigned x;
    volatile LAS unsigned* st;
};

__device__ __forceinline__ XcdBarrier xcd_barrier_post(unsigned* bar, volatile LAS unsigned* st) {
    XcdBarrier b; b.bar = bar; b.x = xb_xcc_id(); b.st = st;
    if (threadIdx.x == 0) (void)xb_add(&bar[XB_XCNT(b.x)], 1u);
    return b;
}
__device__ __forceinline__ void xcd_barrier_complete(unsigned* bar, unsigned x, unsigned& nloc, unsigned& nx) {
    const unsigned G = gridDim.x * gridDim.y * gridDim.z;
    unsigned sum, cnt, mine, sp = 0u;
    for (;;) {
        sum = 0u; cnt = 0u; mine = 0u;
#pragma unroll
        for (unsigned j = 0; j < 16; ++j) { const unsigned c = xb_ld(&bar[XB_XCNT(j)]); sum += c; cnt += (c > 0u) ? 1u : 0u; mine = (j == x) ? c : mine; }
        if (sum == G) break;
        __builtin_amdgcn_s_sleep(1);
        if ((++sp & 255u) == 0u) { if (xb_ld(&bar[XB_TMO])) break; if (sp > XB_SPIN_CAP) { atomicAdd(&bar[XB_TMO], 1u); break; } }
    }
    nloc = mine > 0u ? mine : 1u; nx = cnt > 0u ? cnt : 1u;
}

__device__ __forceinline__ void xcd_barrier(const XcdBarrier& b) {
    asm volatile("s_waitcnt vmcnt(0)" ::: "memory");
    __syncthreads();
    if (threadIdx.x == 0) {
        unsigned* bar = b.bar;
        __builtin_amdgcn_s_waitcnt(0);
        unsigned nloc = b.st[0], nx = b.st[1];
        if (nloc == 0u) { xcd_barrier_complete(bar, b.x, nloc, nx); b.st[0] = nloc; b.st[1] = nx; }
        const unsigned old = xb_add(&bar[XB_XSUB(b.x)], 1u);
        const unsigned gen = old / nloc;
        if (old + 1u == (gen + 1u) * nloc) {
            __builtin_amdgcn_fence(__ATOMIC_RELEASE, "agent");
            asm volatile("s_waitcnt vmcnt(0)" ::: "memory");
            const unsigned og = xb_add(&bar[XB_TOP], 1u);
            const unsigned tg = og / nx;
            if (og + 1u == (tg + 1u) * nx) xb_add(&bar[XB_TOPGEN], 1u);
            else XB_SPIN(xb_ld(&bar[XB_TOPGEN]) == tg, bar);
            __builtin_amdgcn_fence(__ATOMIC_ACQUIRE, "agent");
            xb_add(&bar[XB_XGEN(b.x)], 1u);
            asm volatile("s_waitcnt vmcnt(0)" ::: "memory");
        } else {
            XB_SPIN(xb_ld(&bar[XB_XGEN(b.x)]) == gen, bar);
            __builtin_amdgcn_fence(__ATOMIC_ACQUIRE, "agent");
            asm volatile("s_waitcnt vmcnt(0)" ::: "memory");
        }
    }
    __syncthreads();
}

constexpr int N_PHASES = 28;
__global__ void __launch_bounds__(NT, 2) yoco_fwd(Par p_in) {
    extern __shared__ __attribute__((aligned(16))) unsigned char lds_raw[];
    LAS unsigned char* lds = (LAS unsigned char*)lds_raw;
    cg::grid_group grid = cg::this_grid();
    const int lo = p_in.ph_lo, hi = p_in.ph_hi;
    const int wave0 = __builtin_amdgcn_readfirstlane((int)threadIdx.x >> 6);
    if (blockIdx.x == 0) for (int q = threadIdx.x; q < XCD_BAR_WORDS; q += NT) __hip_atomic_store((unsigned*)p_in.ws + q, 0u, __ATOMIC_RELAXED, __HIP_MEMORY_SCOPE_AGENT);
    volatile LAS unsigned* bst = (volatile LAS unsigned*)(lds + LDS_BYTES - 16);
    if (threadIdx.x < 4) bst[threadIdx.x] = 0u;
    __syncthreads();
    XcdBarrier xbar; xbar.bar = (unsigned*)p_in.ws; xbar.x = 0; xbar.st = bst;
    int nbar = 0;
#pragma unroll 1
    for (int it_ = 2 * lo; it_ < 2 * hi; ++it_) {
        const int ph = it_ >> 1;
        const CPar* kp_ = (const CPar*)__builtin_amdgcn_kernarg_segment_ptr(); asm volatile("" : "+s"(kp_)); const CPar& p = *kp_;
        const int wave = lnd_s(wave0), tid = lnd_v((wave << 6) | (int)__builtin_amdgcn_mbcnt_hi(~0u, __builtin_amdgcn_mbcnt_lo(~0u, 0u))), lane = tid & 63;
        const int G = lnd_s((int)gridDim.x), bid = lnd_s((int)blockIdx.x), gw = bid * NW + wave, NGW = G * NW;
        unsigned char* ws = lnd(p.ws);
        float* X = (float*)(ws + WS_X); bf16* XN = (bf16*)(ws + WS_XN); bf16* BIG = (bf16*)(ws + WS_BIG); float* SSb = (float*)(ws + WS_SS);
        int l, k;
        if (ph == 0) { l = 0; k = 0; }
        else if (ph < 15) { l = (ph - 1) / 7; const int j = (ph - 1) % 7; k = (j < 5) ? 1 + j : 2 + j; }
        else if (ph < 27) { l = 2 + (ph - 15) / 6; const int j = (ph - 15) % 6; k = (j < 4) ? 10 + j : 11 + j; }
        else { l = 3; k = 17; }
#ifndef PROBE_DUP
#define PROBE_DUP 0
#endif
#ifndef PROBE_DUPPH
#define PROBE_DUPPH 0ull
#endif
#ifndef PROBE_SYNC
#define PROBE_SYNC 0
#endif
        if ((it_ & 1) && !((PROBE_DUP >> k) & 1) && !((PROBE_DUPPH >> ph) & 1)) continue;
        {
        if (k == 0) { p0_weights(p, lds, gw, NGW, wave, lane, 0, (G > 64) ? P0_NA : P0_NITEMS); p0_prologue(p, lds, gw, NGW, wave, lane); }
        else if (k == 1) {
            pg8::Gemm g{XN, (const bf16*)(ws + WS_WIN) + (size_t)l * NPROJ_PAD * D, MPR, 4096, D}; pg8::StaticOrder S; S.init(MPR, 4096, G, bid);
            EpiProj E{BIG, SSb + (size_t)(2 * l) * MPR};
            pg8::gemm_phase<EpiProj, pg8::StaticOrder, true, true>(lds, g, S, E, tid);
            mini_items(p, 0, l, k, bid, G, tid, lds);
        } else if (k == 2) {
#ifndef NO_PREP
            for (int pi = bid; pi < 1024; pi += G) gdn_prep_pair(p, l, pi, lds, tid);
#endif
        } else if (k == 3) {
#ifndef NO_SCAN
            const int nscan = (G > 64) ? 64 : 0;
#ifndef PROBE_DRY
#define PROBE_DRY 0
#endif
            if (bid < nscan) { const int sit = (((bid & 7) * 2 + (bid >> 5)) << 2) | ((bid >> 3) & 3); if (PROBE_DRY) gdn_scan<PROBE_DRY>(p, l, sit, lds, tid); gdn_scan<0>(p, l, sit, lds, tid); }
            else {
                const int wid = bid - nscan, nwk = G - nscan;
                if (nscan == 0) for (int it = bid; it < 64; it += G) gdn_scan<0>(p, l, it, lds, tid);
                for (int it = wid; it < NS * 8; it += nwk) gdn_decode(p, l, it, lds, tid);
                if (l == 0 && nscan) { __syncthreads(); p0_weights(p, lds, wid * NW + wave, nwk * NW, wave, lane, P0_NA, P0_NITEMS); }
                kv_shift_copy(p, wid, nwk, tid, nscan ? (l == 0 ? 1 : 0) : 2);
            }
#endif
        } else if (k == 4) gdn_gate_rows(p, l, gw, NGW, lane);
        else if (k == 5 || k == 8 || k == 13 || k == 16) {
            const bf16* A; const bf16* Bt; int K;
            if (k == 5) { A = (const bf16*)(ws + WS_OG); Bt = (const bf16*)(ws + WS_WOUT) + (size_t)l * D * D; K = D; }
            else if (k == 13) { A = (const bf16*)(ws + WS_ATT); Bt = (const bf16*)(ws + WS_WO) + (size_t)(l - 2) * D * 512; K = 512; }
            else { A = BIG; Bt = (const bf16*)(ws + WS_WDN) + (size_t)l * D * FF; K = FF; }
            const int ssi = (k == 5 || k == 13) ? 2 * l + 1 : 2 * l + 2;
            pg8::Gemm g{A, Bt, MPR, D, K}; pg8::StaticOrder S; S.init(MPR, D, G, bid);
            EpiRes E{X, XN, SSb + (size_t)ssi * MPR, (k == 5 && l == 0) ? lnd(p.in[0]) : (const float*)X};
            pg8::gemm_phase<EpiRes, pg8::StaticOrder, true, true>(lds, g, S, E, tid);
            mini_items(p, 1, l, k, bid, G, tid, lds);
        } else if (k == 7 || k == 15) {
            pg8::Gemm g{XN, (const bf16*)(ws + WS_WUP) + (size_t)l * FF * D, MPR, FF, D}; pg8::StaticOrder S; S.init(MPR, FF, G, bid);
            EpiRelu2 E{BIG, FF, SSb + (size_t)(2 * l + 1) * MPR};
            pg8::gemm_phase<EpiRelu2, pg8::StaticOrder, true, true>(lds, g, S, E, tid);
            mini_items(p, 2, l, k, bid, G, tid, lds);
        } else if (k == 10) {
            const int Nn = (l == 2) ? NQKV2 : NQ;
            pg8::Gemm g{XN, (const bf16*)(ws + (l == 2 ? WS_WQKV2 : WS_WQ3)), MPR, Nn, D}; pg8::StaticOrder S; S.init(MPR, Nn, G, bid);
            EpiQKV E{(bf16*)(ws + WS_QB), (bf16*)(ws + WS_KB), (bf16*)(ws + WS_VB), lnd(p.out), SSb + (size_t)(2 * l) * MPR};
            pg8::gemm_phase<EpiQKV, pg8::StaticOrder, true, true>(lds, g, S, E, tid);
            mini_items(p, 3, l, k, bid, G, tid, lds);
        } else if (k == 11) {
#ifndef NO_ATTN
            for (int it = bid; it < 1536 + 384; it += G) { if (it < 1536) attn_prompt_item(p, it, lds, tid); else attn_decode_item(p, it - 1536, lds, tid); }
#endif
        } else if (k == 12) attn_merge_rows(p, gw, NGW, lane);
        else final_norm(X, lnd(p.in[21]), lnd(p.out), gw, NGW, lane);
        }
        if (it_ + 1 < 2 * hi) {
            if (nbar == 0) grid.sync();
            else xcd_barrier(xbar);
            if (nbar == 0) xbar = xcd_barrier_post((unsigned*)p_in.ws, bst);
            ++nbar;
            for (int e = 0; e < PROBE_SYNC; ++e) xcd_barrier(xbar);
        }
    }
}

extern "C" void kernel_launch(void* const* d_in, const int* in_sizes, int n_in, void* d_out, int out_size, void* d_ws, size_t ws_size, hipStream_t stream) {
    static int grid = 0;
    if (grid == 0) {
        if (n_in != 22 || (size_t)out_size != O_END || ws_size < WS_END) { fprintf(stderr, "kernel_launch: unexpected shapes (n_in %d, out %d, ws %zu)\n", n_in, out_size, ws_size); grid = -1; return; }
        int dev = 0, cus = 0, per_cu = 0;
        if (hipGetDevice(&dev) != hipSuccess || hipDeviceGetAttribute(&cus, hipDeviceAttributeMultiprocessorCount, dev) != hipSuccess) { grid = -1; return; }
        if (hipFuncSetAttribute((const void*)yoco_fwd, hipFuncAttributeMaxDynamicSharedMemorySize, LDS_BYTES) != hipSuccess) { fprintf(stderr, "kernel_launch: hipFuncSetAttribute failed\n"); grid = -1; return; }
        if (hipOccupancyMaxActiveBlocksPerMultiprocessor(&per_cu, (const void*)yoco_fwd, NT, LDS_BYTES) != hipSuccess || per_cu < 1) { fprintf(stderr, "kernel_launch: occupancy query says %d\n", per_cu); grid = -1; return; }
        grid = cus * per_cu;
    }
    if (grid < 0) return;
    Par a{};
    for (int i = 0; i < 22; ++i) a.in[i] = (const float*)d_in[i];
    a.out = (float*)d_out; a.ws = (unsigned char*)d_ws;
#if MK_MULTI
    for (int ph = 0; ph < N_PHASES; ++ph) { a.ph_lo = ph; a.ph_hi = ph + 1; hipLaunchKernelGGL(yoco_fwd, dim3(grid), dim3(NT), LDS_BYTES, stream, a); }
#else
    a.ph_lo = 0; a.ph_hi = N_PHASES;
    void* args[] = {&a};
    hipError_t e = hipLaunchCooperativeKernel((const void*)yoco_fwd, dim3(grid), dim3(NT), args, LDS_BYTES, stream);
    if (e != hipSuccess) fprintf(stderr, "kernel_launch: cooperative launch failed: %s (grid %d)\n", hipGetErrorString(e), grid);
#endif
}
```

```cpp
#include <hip/hip_runtime.h>
#include <hip/hip_cooperative_groups.h>
#include <cstdio>
#include <cstdint>
namespace cg = cooperative_groups;
__device__ __forceinline__ int lnd_v(int x) { asm volatile("" : "+v"(x)); return x; }
__device__ __forceinline__ int lnd_s(int x) { asm volatile("" : "+s"(x)); return x; }
namespace pg8 {
#define PG8_LAS __attribute__((address_space(3)))
typedef unsigned short bf16_t;
typedef short bf16x8 __attribute__((ext_vector_type(8)));
typedef float f32x4 __attribute__((ext_vector_type(4)));
typedef unsigned u32x4 __attribute__((ext_vector_type(4)));
constexpr int BM = 256, BK = 64, HALF = 128, HTB = HALF * BK * 2  , STAGE_BYTES = 8 * HTB, NXCD = 8, WGM = 8;

__host__ __device__ __forceinline__ int lds_byte(int r, int c) { const int st = (r >> 4) * 2 + (c >> 5), rr = r & 15, cc = c & 31, ob = rr * 64 + cc * 2; return st * 1024 + (ob ^ (((ob >> 9) & 1) << 5)); }
__host__ __device__ __forceinline__ void stage_rc(int b, int& R, int& C) { const int st = b / 1024, sb = b % 1024, swz = sb ^ (((sb >> 9) & 1) << 5); R = (st >> 1) * 16 + swz / 64; C = (st & 1) * 32 + (swz % 64) / 2; }
__host__ __device__ __forceinline__ int perm32(int rho) { const int n = rho >> 4, i = rho & 15; return 8 * (i >> 2) + 4 * n + (i & 3); }

struct Unit { int pm, pn; };
struct Gemm { const bf16_t* A; const bf16_t* Bt; int M, N, K; };

struct StaticOrder {
    int nM, nN, nwg, G, c;
    __host__ __device__ void init(int M, int N, int G_, int c_) { nM = M / BM; nN = N / BM; nwg = nM * nN; G = G_; c = c_; }
    __host__ __device__ bool next(int i, Unit& u) const {
        const long L = (long)i * G + c; if (L >= nwg) return false;
        int wgid = (int)L; { const int q = nwg / NXCD, r = nwg % NXCD, xcd = wgid % NXCD, off = wgid / NXCD; wgid = (xcd < r ? xcd * (q + 1) : r * (q + 1) + (xcd - r) * q) + off; }
        const int nig = WGM * nN, gid = wgid / nig, fm = gid * WGM, gsz = (nM - fm) < WGM ? (nM - fm) : WGM;
        u.pm = fm + ((wgid % nig) % gsz); u.pn = (wgid % nig) / gsz; return true;
    }
    __device__ __forceinline__ void a_ready(const Unit&) const {}
    __device__ __forceinline__ void done(const Unit&) const {}
};
__device__ __forceinline__ unsigned cvt_pk_bf16(float lo, float hi) { unsigned r; asm volatile("v_cvt_pk_bf16_f32 %0, %1, %2" : "=v"(r) : "v"(lo), "v"(hi)); return r; }
template <class Epi, class Sched, bool ALIGN_EPI = false, bool SP2 = false>
__device__ __forceinline__ void gemm_phase(PG8_LAS unsigned char* lds, const Gemm g, const Sched& S, const Epi& E, const int tid_in) {
    const int tid = tid_in, wid = __builtin_amdgcn_readfirstlane(tid >> 6), lane = tid & 63, wr = wid >> 2, wc = wid & 3, fr = lane & 15, fq = lane >> 4;
    const int K = g.K, nt = K / BK;
    unsigned voffA[2], voffB[2];
#pragma unroll
    for (int i = 0; i < 2; ++i) { int R, C; stage_rc(tid * 16 + i * 8192, R, C); const int Rb = Epi::PERM ? ((R & ~31) + perm32(R & 31)) : R;
        voffA[i] = (unsigned)(R * K + C) * 2u; voffB[i] = (unsigned)(Rb * K + C) * 2u; }
    const size_t kstep = (size_t)(BK * 2);
    const size_t hstep = (size_t)HALF * K * 2;
    const size_t tstep = 2 * hstep;
    const unsigned ldsw = (unsigned)wid * 1024u;
    const int aoff = lds_byte(wr * 64 + fr, fq * 8), boff = lds_byte(wc * 32 + fr, fq * 8);
#define PG8_SA(b, h) (((b) * 2 + (h)) * HTB)
#define PG8_SB(b, h) ((4 + (b) * 2 + (h)) * HTB)
#define PG8_STAGE(bufoff, gbase, voff) do { _Pragma("unroll") for (int _i = 0; _i < 2; ++_i) \
        __builtin_amdgcn_global_load_lds((const unsigned*)((const char*)(gbase) + (voff)[_i]), (PG8_LAS unsigned*)(lds + (bufoff) + ldsw + _i * 8192), 16, 0, 0); } while (0)
#define PG8_LDA(dst, b, h) do { _Pragma("unroll") for (int m = 0; m < 4; ++m) _Pragma("unroll") for (int k = 0; k < 2; ++k) dst[m][k] = *(const PG8_LAS bf16x8*)(lds + PG8_SA(b, h) + aoff + m * 2048 + k * 1024); } while (0)
#define PG8_LDB(dst, b, h) do { _Pragma("unroll") for (int n = 0; n < 2; ++n) _Pragma("unroll") for (int k = 0; k < 2; ++k) dst[n][k] = *(const PG8_LAS bf16x8*)(lds + PG8_SB(b, h) + boff + n * 2048 + k * 1024); } while (0)
#define PG8_MMA(ai, bj, At, Bt) do { __builtin_amdgcn_s_setprio(1); _Pragma("unroll") for (int m = 0; m < 4; ++m) _Pragma("unroll") for (int n = 0; n < 2; ++n) _Pragma("unroll") for (int k = 0; k < 2; ++k) \
        acc[ai][bj][m][n] = __builtin_amdgcn_mfma_f32_16x16x32_bf16(Bt[n][k], At[m][k], acc[ai][bj][m][n], 0, 0, 0); __builtin_amdgcn_s_setprio(0); } while (0)
#define PG8_WAIT_V(n) asm volatile("s_waitcnt vmcnt(" #n ")" ::: "memory")
#define PG8_WAIT_L(n) asm volatile("s_waitcnt lgkmcnt(" #n ")" ::: "memory")
#define PG8_BAR __builtin_amdgcn_s_barrier()
#define PG8_SCHED __builtin_amdgcn_sched_barrier(0)
    Unit cur, nxt; int ui = 0;
    if (!S.next(0, cur)) return;
    f32x4 acc[2][2][4][2];
#pragma unroll
    for (int a = 0; a < 2; ++a)
#pragma unroll
        for (int b = 0; b < 2; ++b)
#pragma unroll
            for (int m = 0; m < 4; ++m)
#pragma unroll
                for (int n = 0; n < 2; ++n) acc[a][b][m][n] = (f32x4){0.f, 0.f, 0.f, 0.f};
    bf16x8 At[4][2], B0[2][2], B1[2][2];
    const char* cA = (const char*)g.A + (size_t)cur.pm * tstep; const char* cB = (const char*)g.Bt + (size_t)cur.pn * tstep;
    S.a_ready(cur);
    if constexpr (SP2) {
        PG8_STAGE(PG8_SB(0, 0), cB, voffB); PG8_STAGE(PG8_SB(0, 1), cB + hstep, voffB); PG8_STAGE(PG8_SA(0, 0), cA, voffA); PG8_STAGE(PG8_SA(0, 1), cA + hstep, voffA);
        if (wr == 1) PG8_BAR;
        PG8_WAIT_V(2); PG8_BAR;
        PG8_STAGE(PG8_SB(1, 0), cB + kstep, voffB); PG8_STAGE(PG8_SA(1, 0), cA + kstep, voffA); PG8_STAGE(PG8_SB(1, 1), cB + hstep + kstep, voffB);
        PG8_WAIT_V(6); PG8_BAR;
    } else {
        PG8_STAGE(PG8_SB(0, 0), cB, voffB); PG8_STAGE(PG8_SA(0, 0), cA, voffA); PG8_STAGE(PG8_SB(0, 1), cB + hstep, voffB); PG8_STAGE(PG8_SA(0, 1), cA + hstep, voffA);
        if (wr == 1) PG8_BAR;
        PG8_WAIT_V(4); PG8_BAR;
        PG8_STAGE(PG8_SB(1, 0), cB + kstep, voffB); PG8_STAGE(PG8_SA(1, 0), cA + kstep, voffA); PG8_STAGE(PG8_SB(1, 1), cB + hstep + kstep, voffB);
        PG8_WAIT_V(6); PG8_BAR;
    }
    for (;;) {
        const bool has_next = S.next(ui + 1, nxt);
        const char* nA = has_next ? (const char*)g.A + (size_t)nxt.pm * tstep : cA; const char* nB = has_next ? (const char*)g.Bt + (size_t)nxt.pn * tstep : cB;
        for (int t = 0; t < nt; t += 2) {
            const bool last = (t == nt - 2);
            const char* a1 = cA + (size_t)(t + 1) * kstep;
            const char* a2 = last ? nA : cA + (size_t)(t + 2) * kstep; const char* b2 = last ? nB : cB + (size_t)(t + 2) * kstep;
            const char* a3 = a2 + kstep; const char* b3 = b2 + kstep;
            if (last && has_next) S.a_ready(nxt);
            if constexpr (SP2) {
            PG8_LDB(B0, 0, 0); PG8_LDB(B1, 0, 1); PG8_SCHED; PG8_LDA(At, 0, 0); PG8_STAGE(PG8_SA(1, 1), a1 + hstep, voffA);
            PG8_WAIT_V(8); PG8_WAIT_L(0); PG8_BAR; PG8_MMA(0, 0, At, B0); PG8_MMA(0, 1, At, B1); PG8_BAR; PG8_SCHED;
            PG8_LDA(At, 0, 1); PG8_STAGE(PG8_SB(0, 0), b2, voffB); PG8_STAGE(PG8_SB(0, 1), b2 + hstep, voffB); PG8_STAGE(PG8_SA(0, 0), a2, voffA);
            PG8_WAIT_V(8); PG8_WAIT_L(0); PG8_BAR; PG8_MMA(1, 0, At, B0); PG8_MMA(1, 1, At, B1); PG8_BAR; PG8_SCHED;
            PG8_LDB(B0, 1, 0); PG8_LDB(B1, 1, 1); PG8_SCHED; PG8_LDA(At, 1, 0); PG8_STAGE(PG8_SA(0, 1), a2 + hstep, voffA);
            PG8_WAIT_V(8); PG8_WAIT_L(0); PG8_BAR; PG8_MMA(0, 0, At, B0); PG8_MMA(0, 1, At, B1); PG8_BAR; PG8_SCHED;
            PG8_LDA(At, 1, 1); PG8_STAGE(PG8_SB(1, 0), b3, voffB); PG8_STAGE(PG8_SB(1, 1), b3 + hstep, voffB); PG8_STAGE(PG8_SA(1, 0), a3, voffA);
            PG8_WAIT_V(8); PG8_WAIT_L(0); PG8_BAR; PG8_MMA(1, 0, At, B0); PG8_MMA(1, 1, At, B1); PG8_BAR; PG8_SCHED;
            } else {
            PG8_LDB(B0, 0, 0); PG8_SCHED; PG8_LDA(At, 0, 0); PG8_STAGE(PG8_SA(1, 1), a1 + hstep, voffA);
            PG8_WAIT_L(8); PG8_BAR; PG8_WAIT_L(0); PG8_MMA(0, 0, At, B0); PG8_BAR; PG8_SCHED;
            PG8_LDB(B1, 0, 1); PG8_STAGE(PG8_SB(0, 0), b2, voffB);
            PG8_BAR; PG8_WAIT_L(0); PG8_MMA(0, 1, At, B1); PG8_BAR;
            PG8_LDA(At, 0, 1); PG8_STAGE(PG8_SA(0, 0), a2, voffA);
            PG8_BAR; PG8_WAIT_L(0); PG8_MMA(1, 0, At, B0); PG8_BAR; PG8_SCHED;
            PG8_STAGE(PG8_SB(0, 1), b2 + hstep, voffB);
            PG8_WAIT_V(6); PG8_BAR; PG8_MMA(1, 1, At, B1); PG8_BAR;
            PG8_LDB(B0, 1, 0); PG8_SCHED; PG8_LDA(At, 1, 0); PG8_STAGE(PG8_SA(0, 1), a2 + hstep, voffA);
            PG8_WAIT_L(8); PG8_BAR; PG8_WAIT_L(0); PG8_MMA(0, 0, At, B0); PG8_BAR; PG8_SCHED;
            PG8_LDB(B1, 1, 1); PG8_STAGE(PG8_SB(1, 0), b3, voffB);
            PG8_BAR; PG8_WAIT_L(0); PG8_MMA(0, 1, At, B1); PG8_BAR;
            PG8_LDA(At, 1, 1); PG8_STAGE(PG8_SA(1, 0), a3, voffA);
            PG8_BAR; PG8_WAIT_L(0); PG8_MMA(1, 0, At, B0); PG8_BAR; PG8_SCHED;
            PG8_STAGE(PG8_SB(1, 1), b3 + hstep, voffB);
            PG8_WAIT_V(6); PG8_BAR; PG8_MMA(1, 1, At, B1); PG8_BAR;
            }
        }
        if constexpr (ALIGN_EPI) { if (wr == 0) PG8_BAR; }
        if constexpr (!Epi::AFTER_DRAIN) { E(acc, cur, wr, wc, fr, fq); S.done(cur); }
        if (!has_next) break;
#pragma unroll
        for (int a = 0; a < 2; ++a)
#pragma unroll
            for (int b = 0; b < 2; ++b)
#pragma unroll
                for (int m = 0; m < 4; ++m)
#pragma unroll
                    for (int n = 0; n < 2; ++n) acc[a][b][m][n] = (f32x4){0.f, 0.f, 0.f, 0.f};
        cur = nxt; cA = nA; cB = nB; ++ui;
        if constexpr (ALIGN_EPI) { if (wr == 1) PG8_BAR; }
    }
    PG8_WAIT_V(0);
    if constexpr (!ALIGN_EPI) { if (wr == 0) PG8_BAR; }
    PG8_BAR;
    if constexpr (Epi::AFTER_DRAIN) { E.fused(acc, cur, wr, wc, fr, fq, lds, wid, lane); S.done(cur); }
#undef PG8_SA
#undef PG8_SB
#undef PG8_STAGE
#undef PG8_LDA
#undef PG8_LDB
#undef PG8_MMA
#undef PG8_WAIT_V
#undef PG8_WAIT_L
#undef PG8_BAR
#undef PG8_SCHED
}
}

#ifndef MK_MULTI
#define MK_MULTI 0
#endif

constexpr int NW = 8, NT = 512;
constexpr int D = 1024, FF = 4096, SEQ = 8192, MPR = 16384, NS = 128, MV = MPR + NS, MP = 16640;
constexpr int NPROJ = 4112, NPROJ_PAD = 4352, NQKV2 = 2304, NQ = 1536;
constexpr float EPS = 1e-6f;
constexpr size_t O_YP = 0, O_YS = 16777216, O_PREC = 16908288, O_PCONV = 17432576, O_PKV0 = 17469440, O_PKV1 = 17534976, O_PKV2 = 17797120,
                 O_SREC = 18845696, O_SCONV = 52400128, O_SKV0 = 54759424, O_SKV1 = 58953728, O_SKV2 = 75730944, O_END = 142839808;
constexpr size_t MiB = 1u << 20;
constexpr size_t WS_WIN = 1 * MiB, WS_WOUT = 19 * MiB, WS_WUP = 23 * MiB, WS_WDN = 55 * MiB, WS_WQKV2 = 87 * MiB, WS_WQ3 = 92 * MiB, WS_WO = 95 * MiB;
constexpr size_t WS_X = 98 * MiB, WS_XN = 164 * MiB, WS_BIG = 198 * MiB, WS_BA = 329 * MiB, WS_O = 331 * MiB, WS_OG = 397 * MiB;
constexpr size_t WS_CW = 430 * MiB, WS_CQD = 462 * MiB, WS_CKDT = 494 * MiB, WS_CATT = 526 * MiB, WS_CU = 542 * MiB, WS_CDL = 606 * MiB;
constexpr size_t WS_QB = 607 * MiB, WS_KB = 655 * MiB, WS_VB = 667 * MiB, WS_QS = 679 * MiB, WS_OB = 680 * MiB, WS_LSE = 729 * MiB, WS_ATT = 731 * MiB, WS_SS = 748 * MiB, WS_END = 749 * MiB;
constexpr int LDS_BYTES = 147456;

#define LAS __attribute__((address_space(3)))
typedef unsigned short bf16;
typedef unsigned v4u __attribute__((ext_vector_type(4)));
typedef unsigned v2u __attribute__((ext_vector_type(2)));
typedef float f32x4 __attribute__((ext_vector_type(4)));
typedef short bf16x8 __attribute__((ext_vector_type(8)));

typedef float f32x2_t __attribute__((ext_vector_type(2)));
typedef __bf16 bf16x2_t __attribute__((ext_vector_type(2)));
__device__ __forceinline__ unsigned pk2(float lo, float hi) { const f32x2_t v = {lo, hi}; const bf16x2_t r = __builtin_convertvector(v, bf16x2_t); return __builtin_bit_cast(unsigned, r); }
__device__ __forceinline__ unsigned f2bf(float f) { return pk2(f, 0.f) & 0xffffu; }
__device__ __forceinline__ float bflo(unsigned w) { return __builtin_bit_cast(float, w << 16); }
__device__ __forceinline__ float bfhi(unsigned w) { return __builtin_bit_cast(float, w & 0xffff0000u); }
__device__ __forceinline__ float bf2f(bf16 h) { return __builtin_bit_cast(float, (unsigned)h << 16); }
template <int M> __device__ __forceinline__ float shx(float v, int lane) {
    if constexpr (M < 32) return __builtin_bit_cast(float, __builtin_amdgcn_ds_swizzle(__builtin_bit_cast(int, v), (M << 10) | 0x1f));
    else return __builtin_bit_cast(float, __builtin_amdgcn_ds_bpermute((lane ^ 32) << 2, __builtin_bit_cast(int, v)));
}
__device__ __forceinline__ float wave_sum(float v, int lane) {
    v += shx<1>(v, lane); v += shx<2>(v, lane); v += shx<4>(v, lane); v += shx<8>(v, lane); v += shx<16>(v, lane); v += shx<32>(v, lane);
    return v;
}
__device__ __forceinline__ float wave_max(float v, int lane) {
    v = fmaxf(v, shx<1>(v, lane)); v = fmaxf(v, shx<2>(v, lane)); v = fmaxf(v, shx<4>(v, lane)); v = fmaxf(v, shx<8>(v, lane)); v = fmaxf(v, shx<16>(v, lane)); v = fmaxf(v, shx<32>(v, lane));
    return v;
}
__device__ __forceinline__ float silu_f(float x) { return x * __builtin_amdgcn_rcpf(1.f + __expf(-x)); }
#define LDSBAR() do { asm volatile("s_waitcnt lgkmcnt(0)" ::: "memory"); __builtin_amdgcn_s_barrier(); asm volatile("" ::: "memory"); } while (0)
#define MFMA16(a, b, c) __builtin_amdgcn_mfma_f32_16x16x32_bf16((a), (b), (c), 0, 0, 0)

template <class T> __device__ __forceinline__ T* lnd(T* q) { __attribute__((address_space(1))) T* g = (__attribute__((address_space(1))) T*)q; asm volatile("" : "+s"(g)); return (T*)g; }
struct Par { const float* in[22]; float* out; unsigned char* ws; int ph_lo, ph_hi; };
typedef __attribute__((address_space(4))) Par CPar;

__device__ __forceinline__ void epi_rstd(const float* ss, int row0, float (&r)[2][4]) {
#pragma unroll
    for (int ai = 0; ai < 2; ++ai)
#pragma unroll
        for (int m = 0; m < 4; ++m) r[ai][m] = rsqrtf(ss[row0 + ai * 128 + m * 16] * (1.f / D) + EPS);
}
struct EpiRelu2 {
    static constexpr bool PERM = true, AFTER_DRAIN = false;
    bf16* O; int ldc; const float* ss;
    __device__ __forceinline__ void operator()(const f32x4 (&acc)[2][2][4][2], const pg8::Unit& u, int wr, int wc, int fr, int fq) const {
        const int row0 = u.pm * 256 + wr * 64 + fr, col0 = u.pn * 256 + wc * 32 + 8 * fq;
        float rs[2][4]; epi_rstd(ss, row0, rs);
#pragma unroll
        for (int ai = 0; ai < 2; ++ai)
#pragma unroll
            for (int m = 0; m < 4; ++m) { bf16* rowp = O + (size_t)(row0 + ai * 128 + m * 16) * ldc + col0;
#pragma unroll
                for (int bj = 0; bj < 2; ++bj) { f32x4 v0 = acc[ai][bj][m][0] * rs[ai][m], v1 = acc[ai][bj][m][1] * rs[ai][m];
#pragma unroll
                    for (int e = 0; e < 4; ++e) { float a = fmaxf(v0[e], 0.f), b = fmaxf(v1[e], 0.f); v0[e] = a * a; v1[e] = b * b; }
                    v4u w; w.x = pk2(v0[0], v0[1]); w.y = pk2(v0[2], v0[3]); w.z = pk2(v1[0], v1[1]); w.w = pk2(v1[2], v1[3]);
                    *(v4u*)(rowp + bj * 128) = w; } }
    }
};
struct EpiRes {
    static constexpr bool PERM = true, AFTER_DRAIN = false;
    float* X; bf16* XB; float* ss; const float* Xsrc;
    __device__ __forceinline__ void operator()(const f32x4 (&acc)[2][2][4][2], const pg8::Unit& u, int wr, int wc, int fr, int fq) const {
        const int row0 = u.pm * 256 + wr * 64 + fr, col0 = u.pn * 256 + wc * 32 + 8 * fq, lane = fr + 16 * fq;
#pragma unroll
        for (int ai = 0; ai < 2; ++ai) {
            f32x4 xa[4][2][2];
#pragma unroll
            for (int m = 0; m < 4; ++m)
#pragma unroll
                for (int bj = 0; bj < 2; ++bj) { const f32x4* p0 = (const f32x4*)(Xsrc + (size_t)(row0 + ai * 128 + m * 16) * D + col0 + bj * 128); xa[m][bj][0] = p0[0]; xa[m][bj][1] = p0[1]; }
#pragma unroll
            for (int m = 0; m < 4; ++m) { const int row = row0 + ai * 128 + m * 16; float* rowp = X + (size_t)row * D + col0; bf16* xb = XB + (size_t)row * D + col0; float sq = 0.f;
#pragma unroll
                for (int bj = 0; bj < 2; ++bj) { f32x4* p0 = (f32x4*)(rowp + bj * 128); const f32x4 a = xa[m][bj][0] + acc[ai][bj][m][0], b = xa[m][bj][1] + acc[ai][bj][m][1]; p0[0] = a; p0[1] = b;
                    sq += (a[0] * a[0] + a[1] * a[1]) + (a[2] * a[2] + a[3] * a[3]) + (b[0] * b[0] + b[1] * b[1]) + (b[2] * b[2] + b[3] * b[3]);
                    v4u w; w.x = pk2(a[0], a[1]); w.y = pk2(a[2], a[3]); w.z = pk2(b[0], b[1]); w.w = pk2(b[2], b[3]);
                    *(v4u*)(xb + bj * 128) = w; }
                sq += shx<16>(sq, lane); sq += shx<32>(sq, lane);
                if (fq == 0) unsafeAtomicAdd(ss + row, sq); }
        }
    }
};
struct EpiProj {
    static constexpr bool PERM = true, AFTER_DRAIN = false;
    bf16* QKVZ; const float* ss;
    __device__ __forceinline__ void operator()(const f32x4 (&acc)[2][2][4][2], const pg8::Unit& u, int wr, int wc, int fr, int fq) const {
        const int row0 = u.pm * 256 + wr * 64 + fr, col0 = u.pn * 256 + wc * 32 + 8 * fq;
        float rs[2][4]; epi_rstd(ss, row0, rs);
#pragma unroll
        for (int ai = 0; ai < 2; ++ai)
#pragma unroll
            for (int m = 0; m < 4; ++m) { const int row = row0 + ai * 128 + m * 16;
#pragma unroll
                for (int bj = 0; bj < 2; ++bj) { const int c = col0 + bj * 128; const f32x4 v0 = acc[ai][bj][m][0] * rs[ai][m], v1 = acc[ai][bj][m][1] * rs[ai][m];
                    v4u w; w.x = pk2(v0[0], v0[1]); w.y = pk2(v0[2], v0[3]); w.z = pk2(v1[0], v1[1]); w.w = pk2(v1[2], v1[3]);
                    *(v4u*)(QKVZ + (size_t)row * 4096 + c) = w; } }
    }
};
struct EpiQKV {
    static constexpr bool PERM = true, AFTER_DRAIN = false;
    bf16 *Qb, *Kb, *Vb; float* out; const float* ss;
    __device__ __forceinline__ void operator()(const f32x4 (&acc)[2][2][4][2], const pg8::Unit& u, int wr, int wc, int fr, int fq) const {
        const int row0 = u.pm * 256 + wr * 64 + fr, col0 = u.pn * 256 + wc * 32 + 8 * fq;
        float rs[2][4]; epi_rstd(ss, row0, rs);
#pragma unroll
        for (int ai = 0; ai < 2; ++ai)
#pragma unroll
            for (int m = 0; m < 4; ++m) { const int row = row0 + ai * 128 + m * 16; const int n = row >> 13, i = row & 8191;
#pragma unroll
                for (int bj = 0; bj < 2; ++bj) { const int c = col0 + bj * 128; const f32x4 v0 = acc[ai][bj][m][0] * rs[ai][m], v1 = acc[ai][bj][m][1] * rs[ai][m];
                    v4u w; w.x = pk2(v0[0], v0[1]); w.y = pk2(v0[2], v0[3]); w.z = pk2(v1[0], v1[1]); w.w = pk2(v1[2], v1[3]);
                    if (c < NQ) {
                        const int b = c >> 9, head = (c >> 6) & 7, dim0 = c & 63, sh = 2 * b, pr = ((i & ((1 << sh) - 1)) << (13 - sh)) + (i >> sh);
                        *(v4u*)(Qb + ((size_t)(((b * 2 + n) * 8 + head) * 8192 + pr)) * 64 + dim0) = w;
                    } else {
                        const int cc = c - NQ, b = cc >> 8, kvsel = (cc >> 7) & 1, g = (cc >> 6) & 1, dim0 = cc & 63, Wb = 128 << (2 * b), sh = 2 * b, pr = ((i & ((1 << sh) - 1)) << (13 - sh)) + (i >> sh);
                        const size_t ob = (b == 0) ? O_PKV0 : (b == 1 ? O_PKV1 : O_PKV2);
                        bf16* dst = kvsel ? Vb : Kb;
                        *(v4u*)(dst + ((size_t)(((b * 2 + n) * 2 + g) * 8192 + pr)) * 64 + dim0) = w;
                        if (i >= SEQ - Wb) { f32x4* p0 = (f32x4*)(out + ob + ((size_t)n * Wb + (i - (SEQ - Wb))) * 256 + (cc & 255)); p0[0] = v0; p0[1] = v1; }
                    } } }
    }
};

template <bool AF32> __device__ __forceinline__ f32x4 mini_core(const void* A, int lda, int row, const bf16* Bt, int ldb, int brow, int k0, int klen, int fq, int lane, float& ssq) {
    f32x4 acc = {0.f, 0.f, 0.f, 0.f}; float sq = 0.f;
    const bf16* bp = Bt + (size_t)brow * ldb + k0 + fq * 8;
    if constexpr (AF32) {
        const float* ap = (const float*)A + (size_t)row * lda + k0 + fq * 8;
#pragma unroll 4
        for (int ks = 0; ks < klen / 32; ++ks) { const f32x4 x0 = *(const f32x4*)(ap + ks * 32), x1 = *(const f32x4*)(ap + ks * 32 + 4); const bf16x8 bf = *(const bf16x8*)(bp + ks * 32);
            sq += (x0[0] * x0[0] + x0[1] * x0[1]) + (x0[2] * x0[2] + x0[3] * x0[3]) + (x1[0] * x1[0] + x1[1] * x1[1]) + (x1[2] * x1[2] + x1[3] * x1[3]);
            v4u aw; aw.x = pk2(x0[0], x0[1]); aw.y = pk2(x0[2], x0[3]); aw.z = pk2(x1[0], x1[1]); aw.w = pk2(x1[2], x1[3]);
            acc = MFMA16(bf, __builtin_bit_cast(bf16x8, aw), acc); }
        sq += shx<16>(sq, lane); sq += shx<32>(sq, lane);
    } else {
        const bf16* ap = (const bf16*)A + (size_t)row * lda + k0 + fq * 8;
#pragma unroll 4
        for (int ks = 0; ks < klen / 32; ++ks) { const bf16x8 af = *(const bf16x8*)(ap + ks * 32); const bf16x8 bf = *(const bf16x8*)(bp + ks * 32); acc = MFMA16(bf, af, acc); }
    }
    ssq = sq; return acc;
}
__device__ __forceinline__ void mini_items(const CPar& p, int kind, int l, int k, int bid, int G, int tid, LAS unsigned char* lds) {
    unsigned char* ws = lnd(p.ws);
    const int w = tid >> 6, lane = tid & 63, fr = lane & 15, fq = lane >> 4;
    float* X = (float*)(ws + WS_X);
    if (kind == 0) {
        const bf16* Bt = (const bf16*)(ws + WS_WIN) + (size_t)l * NPROJ_PAD * D; bf16* QKVZ = (bf16*)(ws + WS_BIG); float* BA = (float*)(ws + WS_BA);
        for (int it = G - 1 - bid; it < 257 + 128; it += G) {
            float ssq;
            if (it < 257) { const int c0 = it * 16, r = 16 * w + fr;
                const f32x4 acc = mini_core<true>(X, D, MPR + r, Bt, D, c0 + fr, 0, D, fq, lane, ssq); const f32x4 v = acc * rsqrtf(ssq * (1.f / D) + EPS); const int col = c0 + 4 * fq;
                if (col < 4096) { v2u o; o.x = pk2(v[0], v[1]); o.y = pk2(v[2], v[3]); *(v2u*)(QKVZ + (size_t)(MPR + r) * 4096 + col) = o; }
                else *(f32x4*)(BA + (size_t)(MPR + r) * 16 + (col - 4096)) = v;
            } else { const int row = (it - 257) * 128 + 16 * w + fr;
                const f32x4 acc = mini_core<false>(ws + WS_XN, D, row, Bt, D, 4096 + fr, 0, D, fq, lane, ssq);
                const float rstd = rsqrtf(((const float*)(ws + WS_SS))[(size_t)(2 * l) * MPR + row] * (1.f / D) + EPS);
                *(f32x4*)(BA + (size_t)row * 16 + 4 * fq) = acc * rstd; }
        }
    } else if (kind == 1) {
        const bf16* A; const bf16* Bt; int K;
        if (k == 5) { A = (const bf16*)(ws + WS_OG); Bt = (const bf16*)(ws + WS_WOUT) + (size_t)l * D * D; K = D; }
        else if (k == 13) { A = (const bf16*)(ws + WS_ATT); Bt = (const bf16*)(ws + WS_WO) + (size_t)(l - 2) * D * 512; K = 512; }
        else { A = (const bf16*)(ws + WS_BIG); Bt = (const bf16*)(ws + WS_WDN) + (size_t)l * D * FF; K = FF; }
        LAS f32x4* red = (LAS f32x4*)lds;
        for (int it = G - 1 - bid; it < 256; it += G) { const int c0 = (it >> 2) * 16, r = (it & 3) * 32 + 16 * (w & 1) + fr, kq = w >> 1; float ssq;
            const f32x4 acc = mini_core<false>(A, K, MPR + r, Bt, K, c0 + fr, kq * (K / 4), K / 4, fq, lane, ssq);
            if (kq) red[((kq - 1) * 2 + (w & 1)) * 64 + lane] = acc;
            __syncthreads();
            if (!kq) { f32x4* xp = (f32x4*)(X + (size_t)(MPR + r) * D + c0 + 4 * fq); *xp = *xp + ((acc + red[(w & 1) * 64 + lane]) + (red[(2 + (w & 1)) * 64 + lane] + red[(4 + (w & 1)) * 64 + lane])); }
            __syncthreads(); }
    } else if (kind == 2) {
        const bf16* Bt = (const bf16*)(ws + WS_WUP) + (size_t)l * FF * D; bf16* H = (bf16*)(ws + WS_BIG);
        for (int it = G - 1 - bid; it < 256; it += G) { const int c0 = it * 16, r = 16 * w + fr; float ssq;
            const f32x4 acc = mini_core<true>(X, D, MPR + r, Bt, D, c0 + fr, 0, D, fq, lane, ssq); const f32x4 v = acc * rsqrtf(ssq * (1.f / D) + EPS);
            float t[4];
#pragma unroll
            for (int e = 0; e < 4; ++e) { const float a = fmaxf(v[e], 0.f); t[e] = a * a; }
            v2u o; o.x = pk2(t[0], t[1]); o.y = pk2(t[2], t[3]); *(v2u*)(H + (size_t)(MPR + r) * FF + c0 + 4 * fq) = o; }
    } else {
        const bf16* Bt = (const bf16*)(ws + (l == 2 ? WS_WQKV2 : WS_WQ3)); const int nch = (l == 2 ? NQKV2 : NQ) / 16; bf16* Qs = (bf16*)(ws + WS_QS); float* out = lnd(p.out);
        for (int it = G - 1 - bid; it < nch; it += G) { const int c0 = it * 16, r = 16 * w + fr; float ssq;
            const f32x4 acc = mini_core<true>(X, D, MPR + r, Bt, D, c0 + fr, 0, D, fq, lane, ssq); const f32x4 v = acc * rsqrtf(ssq * (1.f / D) + EPS); const int col = c0 + 4 * fq;
            if (col < NQ) { v2u o; o.x = pk2(v[0], v[1]); o.y = pk2(v[2], v[3]); *(v2u*)(Qs + (size_t)r * NQ + col) = o; }
            else { const int cc = col - NQ, b = cc >> 8, Wb = 128 << (2 * b); const size_t os = (b == 0) ? O_SKV0 : (b == 1 ? O_SKV1 : O_SKV2);
                *(f32x4*)(out + os + ((size_t)r * Wb + (Wb - 1)) * 256 + (cc & 255)) = v; } }
    }
}

__device__ __forceinline__ void p0_transpose_item(const float* W, int K, int Nsrc, int Npad, const float* gain, bf16* WT, int row_off, LAS float* scr, int item, int lane) {
    const int nblk = Npad / 64, kb = item / nblk, nb = item % nblk, k0 = 64 * kb, n0 = 64 * nb;
    const int nn = n0 + 4 * (lane & 15);
#pragma unroll 8
    for (int i = 0; i < 16; ++i) { const int kk = 4 * i + (lane >> 4); f32x4 v = {0.f, 0.f, 0.f, 0.f};
        if (nn < Nsrc) v = __builtin_nontemporal_load((const f32x4*)(W + (size_t)(k0 + kk) * Nsrc + nn));
        if (gain) v = v * gain[k0 + kk];
        LAS float* d = scr + kk * 65 + 4 * (lane & 15); d[0] = v[0]; d[1] = v[1]; d[2] = v[2]; d[3] = v[3]; }
    asm volatile("s_waitcnt lgkmcnt(0)" ::: "memory");
    const int c = lane & 7;
#pragma unroll
    for (int j = 0; j < 8; ++j) { const int n = (lane >> 3) + 8 * j; const LAS float* sp = scr + (8 * c) * 65 + n;
        v4u o; o.x = pk2(sp[0 * 65], sp[1 * 65]); o.y = pk2(sp[2 * 65], sp[3 * 65]); o.z = pk2(sp[4 * 65], sp[5 * 65]); o.w = pk2(sp[6 * 65], sp[7 * 65]);
        __builtin_nontemporal_store(o, (v4u*)(WT + (size_t)(row_off + n0 + n) * K + k0 + 8 * c)); }
    asm volatile("s_waitcnt lgkmcnt(0)" ::: "memory");
}
constexpr int I_IN = (D / 64) * (NPROJ_PAD / 64), I_OUT = (D / 64) * (D / 64), I_UP = (D / 64) * (FF / 64), I_DN = (FF / 64) * (D / 64),
              I_Q = (D / 64) * (NQ / 64), I_KV = (D / 64) * (768 / 64), I_O = (512 / 64) * (D / 64);
constexpr int P0_NA = I_IN + I_OUT + I_UP + I_DN, P0_NITEMS = 2 * I_IN + 2 * I_OUT + 4 * I_UP + 4 * I_DN + 2 * I_Q + I_KV + 2 * I_O;
__device__ __forceinline__ void p0_weights(const CPar& p, LAS unsigned char* lds, int gw, int NGW, int wave, int lane, int first, int last) {
    LAS float* scr = (LAS float*)(lds + wave * 17408);
    unsigned char* ws = lnd(p.ws);
    for (int it = first + gw; it < last; it += NGW) {
        int r = it, type, l = 0;
        if (r < P0_NA) { if (r < I_IN) type = 0; else if ((r -= I_IN) < I_OUT) type = 1; else if ((r -= I_OUT) < I_UP) type = 2; else { r -= I_UP; type = 3; } }
        else { r -= P0_NA; l = 1;
            if (r < I_IN) type = 0; else if ((r -= I_IN) < I_OUT) type = 1;
            else if ((r -= I_OUT) < 3 * I_UP) { type = 2; l = 1 + r / I_UP; r %= I_UP; }
            else if ((r -= 3 * I_UP) < 3 * I_DN) { type = 3; l = 1 + r / I_DN; r %= I_DN; }
            else if ((r -= 3 * I_DN) < I_Q) type = 4; else if ((r -= I_Q) < I_KV) type = 5; else if ((r -= I_KV) < I_Q) type = 6; else { r -= I_Q; type = 7; l = r / I_O; r %= I_O; } }
        if (type == 0) p0_transpose_item(lnd(p.in[9]) + (size_t)l * D * NPROJ, D, NPROJ, NPROJ_PAD, lnd(p.in[7]) + l * D, (bf16*)(ws + WS_WIN) + (size_t)l * NPROJ_PAD * D, 0, scr, r, lane);
        else if (type == 1) p0_transpose_item(lnd(p.in[14]) + (size_t)l * D * D, D, D, D, nullptr, (bf16*)(ws + WS_WOUT) + (size_t)l * D * D, 0, scr, r, lane);
        else if (type == 2) p0_transpose_item(lnd(p.in[19]) + (size_t)l * D * FF, D, FF, FF, lnd(p.in[8]) + l * D, (bf16*)(ws + WS_WUP) + (size_t)l * FF * D, 0, scr, r, lane);
        else if (type == 3) p0_transpose_item(lnd(p.in[20]) + (size_t)l * FF * D, FF, D, D, nullptr, (bf16*)(ws + WS_WDN) + (size_t)l * D * FF, 0, scr, r, lane);
        else if (type == 4) p0_transpose_item(lnd(p.in[17]), D, NQ, NQ, lnd(p.in[7]) + 2 * D, (bf16*)(ws + WS_WQKV2), 0, scr, r, lane);
        else if (type == 5) p0_transpose_item(lnd(p.in[16]), D, 768, 768, lnd(p.in[15]), (bf16*)(ws + WS_WQKV2), NQ, scr, r, lane);
        else if (type == 6) p0_transpose_item(lnd(p.in[17]) + (size_t)D * NQ, D, NQ, NQ, lnd(p.in[7]) + 3 * D, (bf16*)(ws + WS_WQ3), 0, scr, r, lane);
        else p0_transpose_item(lnd(p.in[18]) + (size_t)l * 512 * D, 512, D, D, nullptr, (bf16*)(ws + WS_WO) + (size_t)l * D * 512, 0, scr, r, lane);
    }
}
__device__ __forceinline__ void p0_prologue(const CPar& p, LAS unsigned char* lds, int gw, int NGW, int wave, int lane) {
    unsigned char* ws = lnd(p.ws);
    float* X = (float*)(ws + WS_X); bf16* XN = (bf16*)(ws + WS_XN); float* SS = (float*)(ws + WS_SS);
    for (int m = gw; m < MV; m += NGW) {
        const float* src = (m < MPR) ? lnd(p.in[0]) + (size_t)m * D : lnd(p.in[1]) + (size_t)(m - MPR) * D;
        const f32x4* xr = (const f32x4*)src + lane; f32x4 v[4]; float s = 0.f;
#pragma unroll
        for (int j = 0; j < 4; ++j) { v[j] = xr[64 * j]; s += (v[j].x * v[j].x + v[j].y * v[j].y) + (v[j].z * v[j].z + v[j].w * v[j].w); }
        if (m >= MPR) { f32x4* xo = (f32x4*)(X + (size_t)m * D) + lane;
#pragma unroll
            for (int j = 0; j < 4; ++j) xo[64 * j] = v[j]; }
        if (m < MPR) { s = wave_sum(s, lane); v2u* o8 = (v2u*)(XN + (size_t)m * D) + lane;
#pragma unroll
            for (int j = 0; j < 4; ++j) { v2u o; o.x = pk2(v[j].x, v[j].y); o.y = pk2(v[j].z, v[j].w); o8[64 * j] = o; }
            if (lane == 0) SS[m] = s; }
    }
    for (int e = gw * 64 + lane; e < 8 * MPR; e += NGW * 64) __hip_atomic_store(SS + MPR + e, 0.f, __ATOMIC_RELAXED, __HIP_MEMORY_SCOPE_AGENT);
}
__device__ __forceinline__ void final_norm(const float* X, const float* gain, float* out, int gw, int NGW, int lane) {
    for (int m = gw; m < MV; m += NGW) {
        const f32x4* xr = (const f32x4*)(X + (size_t)m * D) + lane; f32x4 v[4]; float s = 0.f;
#pragma unroll
        for (int j = 0; j < 4; ++j) { v[j] = xr[64 * j]; s += (v[j].x * v[j].x + v[j].y * v[j].y) + (v[j].z * v[j].z + v[j].w * v[j].w); }
        const float rstd = rsqrtf(wave_sum(s, lane) * (1.f / D) + EPS);
        f32x4* o = (f32x4*)(out + (size_t)m * D) + lane; const f32x4* gp = (const f32x4*)gain + lane;
#pragma unroll
        for (int j = 0; j < 4; ++j) { const f32x4 g = gp[64 * j]; o[64 * j] = v[j] * rstd * g; }
    }
}

__device__ __forceinline__ void gdn_prep_pair(const CPar& p, int l, int pi, LAS unsigned char* lds, int tid_) {
    const int tid = lnd_v(tid_);
    const int sub = tid >> 8, t = tid & 255, wv = t >> 6, lane = t & 63, fr = lane & 15, fq = lane >> 4;
    const int item = 2 * pi + sub, n = item >> 10, c = (item >> 3) & 127, h = item & 7, sid = ((n * 8 + h) << 7) + c;
    LAS unsigned char* base = lds + sub * 70400;
    LAS bf16* QT = (LAS bf16*)base; LAS bf16* KT = QT + 64 * 136; LAS bf16* VT = KT + 64 * 136;
    LAS float* LM = (LAS float*)(base + 3 * 17408); LAS float* GB = LM + 64 * 68;
    unsigned char* ws = lnd(p.ws);
    const bf16* qkvz = (const bf16*)(ws + WS_BIG); const float* BA = (const float*)(ws + WS_BA);
    const float* cw = lnd(p.in[10]) + (size_t)l * 4 * 3072;
    float braw = 0.f, araw = 0.f;
    if (wv == 0) { const size_t m = (size_t)n * SEQ + c * 64 + lane; braw = BA[m * 16 + h]; araw = BA[m * 16 + 8 + h]; }
#pragma unroll 1
    for (int part = 0; part < 3; ++part) {
        const int col = part * 1024 + h * 128 + fr * 8;
        float w[4][8];
#pragma unroll
        for (int jj = 0; jj < 4; ++jj) { const f32x4 a = *(const f32x4*)(cw + jj * 3072 + col), b = *(const f32x4*)(cw + jj * 3072 + col + 4);
            w[jj][0] = a.x; w[jj][1] = a.y; w[jj][2] = a.z; w[jj][3] = a.w; w[jj][4] = b.x; w[jj][5] = b.y; w[jj][6] = b.z; w[jj][7] = b.w; }
        LAS bf16* tile = (part == 0) ? QT : (part == 1 ? KT : VT);
        v4u xx[4][4];
#pragma unroll
        for (int ps = 0; ps < 4; ++ps)
#pragma unroll
            for (int jj = 0; jj < 4; ++jj) { const int ii = c * 64 + ps * 16 + wv * 4 + fq - 3 + jj, iic = ii < 0 ? 0 : ii;
                xx[ps][jj] = *(const v4u*)(qkvz + ((size_t)n * SEQ + iic) * 4096 + col); }
#pragma unroll
        for (int ps = 0; ps < 4; ++ps) {
            const int r = ps * 16 + wv * 4 + fq, i = c * 64 + r;
            float a[8];
#pragma unroll
            for (int e = 0; e < 8; ++e) a[e] = 0.f;
#pragma unroll
            for (int jj = 0; jj < 4; ++jj) { const v4u x = xx[ps][jj]; const float gd = (i - 3 + jj >= 0) ? 1.f : 0.f;
                a[0] += gd * w[jj][0] * bflo(x.x); a[1] += gd * w[jj][1] * bfhi(x.x); a[2] += gd * w[jj][2] * bflo(x.y); a[3] += gd * w[jj][3] * bfhi(x.y);
                a[4] += gd * w[jj][4] * bflo(x.z); a[5] += gd * w[jj][5] * bfhi(x.z); a[6] += gd * w[jj][6] * bflo(x.w); a[7] += gd * w[jj][7] * bfhi(x.w); }
            float ss = 0.f;
#pragma unroll
            for (int e = 0; e < 8; ++e) { a[e] = silu_f(a[e]); ss += a[e] * a[e]; }
            if (part < 2) {
                ss += shx<1>(ss, lane); ss += shx<2>(ss, lane); ss += shx<4>(ss, lane); ss += shx<8>(ss, lane);
                const float sc = rsqrtf(ss + EPS) * (part == 0 ? 0.08838834764831845f : 1.f);
#pragma unroll
                for (int e = 0; e < 8; ++e) a[e] *= sc;
            }
            v4u o; o.x = pk2(a[0], a[1]); o.y = pk2(a[2], a[3]); o.z = pk2(a[4], a[5]); o.w = pk2(a[6], a[7]);
            *(LAS v4u*)(tile + r * 136 + fr * 8) = o;
        }
    }
    if (wv == 0) {
        const float beta = 1.f / (1.f + expf(-braw));
        const float xx = araw + lnd(p.in[12])[l * 8 + h]; const float sp = xx > 20.f ? xx : log1pf(expf(xx));
        float g = -expf(lnd(p.in[11])[l * 8 + h]) * sp;
#pragma unroll
        for (int o = 1; o < 64; o <<= 1) { const float y = __builtin_bit_cast(float, __builtin_amdgcn_ds_bpermute(((lane - o) & 63) << 2, __builtin_bit_cast(int, g))); if (lane >= o) g += y; }
        GB[lane] = g; GB[64 + lane] = beta;
    }
    LDSBAR();
    {
        bf16x8 bk[4], bq[4];
#pragma unroll
        for (int ks = 0; ks < 4; ++ks) { bk[ks] = *(const LAS bf16x8*)(KT + (16 * wv + fr) * 136 + ks * 32 + fq * 8); bq[ks] = *(const LAS bf16x8*)(QT + (16 * wv + fr) * 136 + ks * 32 + fq * 8); }
        const int i = 16 * wv + fr; const float Gi = GB[i], bi = GB[64 + i];
        bf16* attn = (bf16*)(ws + WS_CATT) + (size_t)sid * 4096;
#pragma unroll
        for (int jt = 0; jt < 4; ++jt) {
            f32x4 Lv = {0.f, 0.f, 0.f, 0.f}, Av = {0.f, 0.f, 0.f, 0.f};
            if (jt <= wv) {
                f32x4 akk = {0.f, 0.f, 0.f, 0.f}, aqk = {0.f, 0.f, 0.f, 0.f};
#pragma unroll
                for (int ks = 0; ks < 4; ++ks) { const bf16x8 a = *(const LAS bf16x8*)(KT + (16 * jt + fr) * 136 + ks * 32 + fq * 8); akk = MFMA16(a, bk[ks], akk); aqk = MFMA16(a, bq[ks], aqk); }
#pragma unroll
                for (int e = 0; e < 4; ++e) { const int j = 16 * jt + 4 * fq + e; const float dd = __expf(fminf(Gi - GB[j], 0.f));
                    Lv[e] = (i > j) ? bi * akk[e] * dd : 0.f; Av[e] = (i >= j) ? aqk[e] * dd : 0.f; }
            }
#pragma unroll
            for (int e = 0; e < 4; ++e) LM[(16 * jt + 4 * fq + e) * 68 + i] = Lv[e];
            v2u o; o.x = pk2(Av[0], Av[1]); o.y = pk2(Av[2], Av[3]);
            *(v2u*)(attn + i * 64 + 16 * jt + 4 * fq) = o;
        }
    }
    LDSBAR();
    {
        float u[64];
        if (t < 128) {
#pragma unroll
            for (int i = 0; i < 64; ++i) u[i] = bf2f(VT[i * 136 + t]) * GB[64 + i];
        } else {
#pragma unroll
            for (int i = 0; i < 64; ++i) u[i] = bf2f(KT[i * 136 + (t - 128)]) * GB[64 + i] * __expf(GB[i]);
        }
        {
            f32x2_t u2[32];
#pragma unroll
            for (int k2 = 0; k2 < 32; ++k2) u2[k2] = (f32x2_t){u[2 * k2], u[2 * k2 + 1]};
#pragma unroll
            for (int j = 0; j < 63; ++j) {
                const float ujs = (j & 1) ? u2[j >> 1].y : u2[j >> 1].x; const f32x2_t uj = {ujs, ujs};
#pragma unroll
                for (int i4 = (j + 1) / 4; i4 < 16; ++i4) { const f32x4 lv = *(const LAS f32x4*)(LM + j * 68 + 4 * i4);
                    u2[2 * i4] -= (f32x2_t){lv.x, lv.y} * uj; u2[2 * i4 + 1] -= (f32x2_t){lv.z, lv.w} * uj; }
                __builtin_amdgcn_sched_barrier(0);
            }
#pragma unroll
            for (int k2 = 0; k2 < 32; ++k2) { u[2 * k2] = u2[k2].x; u[2 * k2 + 1] = u2[k2].y; }
        }
        LDSBAR();
        if (t < 128) {
            float* U = (float*)(ws + WS_CU) + (size_t)sid * 8192;
            const int dq = t >> 5, nt = (t >> 4) & 1, f = t & 15;
#pragma unroll
            for (int mt = 0; mt < 4; ++mt)
#pragma unroll
                for (int q4 = 0; q4 < 4; ++q4) { const f32x4 v = {u[16 * mt + 4 * q4], u[16 * mt + 4 * q4 + 1], u[16 * mt + 4 * q4 + 2], u[16 * mt + 4 * q4 + 3]};
                    *(f32x4*)(U + ((size_t)((dq * 8 + mt * 2 + nt) * 64 + q4 * 16 + f)) * 4) = v; }
        } else {
#pragma unroll
            for (int i = 0; i < 64; ++i) VT[i * 136 + (t - 128)] = (bf16)f2bf(u[i]);
        }
    }
    LDSBAR();
    {
        const float Glast = GB[63];
        bf16* Wb = (bf16*)(ws + WS_CW) + (size_t)sid * 8192; bf16* QD = (bf16*)(ws + WS_CQD) + (size_t)sid * 8192; bf16* KDT = (bf16*)(ws + WS_CKDT) + (size_t)sid * 8192;
#pragma unroll
        for (int k = 0; k < 4; ++k) { const int q = t + 256 * k, row = q >> 4, c8 = (q & 15) * 8;
            *(v4u*)(Wb + row * 128 + c8) = *(const LAS v4u*)(VT + row * 136 + c8);
            const v4u x = *(const LAS v4u*)(QT + row * 136 + c8); const float eg = __expf(GB[row]);
            v4u o; o.x = pk2(bflo(x.x) * eg, bfhi(x.x) * eg); o.y = pk2(bflo(x.y) * eg, bfhi(x.y) * eg); o.z = pk2(bflo(x.z) * eg, bfhi(x.z) * eg); o.w = pk2(bflo(x.w) * eg, bfhi(x.w) * eg);
            *(v4u*)(QD + row * 128 + c8) = o;
            const int dk = q >> 3, t8 = (q & 7) * 8; float kv[8];
#pragma unroll
            for (int e = 0; e < 8; ++e) kv[e] = bf2f(KT[(t8 + e) * 136 + dk]) * __expf(Glast - GB[t8 + e]);
            v4u ok; ok.x = pk2(kv[0], kv[1]); ok.y = pk2(kv[2], kv[3]); ok.z = pk2(kv[4], kv[5]); ok.w = pk2(kv[6], kv[7]);
            *(v4u*)(KDT + dk * 64 + t8) = ok; }
        if (t == 0) ((float*)(ws + WS_CDL))[sid] = __expf(Glast);
    }
    LDSBAR();
}

struct ScanRegs { v4u rw[2], rq[2], rk[2], ra; f32x4 ru; float rdl; };
template <int DRY> __device__ __forceinline__ void gdn_scan(const CPar& p, int l, int it, LAS unsigned char* lds, int tid) {
    const int n = it >> 5, h = (it >> 2) & 7, dq = it & 3, sid0 = (n * 8 + h) << 7;
    const int w = tid >> 6, lane = tid & 63, fr = lane & 15, fq = lane >> 4, mt = w >> 1, nt = w & 1;
    LAS bf16* Wt = (LAS bf16*)lds; LAS bf16* QDt = Wt + 64 * 136; LAS bf16* KDTt = QDt + 64 * 136; LAS bf16* At = KDTt + 128 * 72; LAS bf16* VNT = At + 64 * 72; LAS bf16* ST = VNT + 32 * 72;
    unsigned char* ws = lnd(p.ws);
    const bf16* Wb = (const bf16*)(ws + WS_CW); const bf16* QD = (const bf16*)(ws + WS_CQD); const bf16* KDT = (const bf16*)(ws + WS_CKDT); const bf16* ATT = (const bf16*)(ws + WS_CATT);
    const float* U = (const float*)(ws + WS_CU); const float* DL = (const float*)(ws + WS_CDL);
    float* O = (float*)(ws + WS_O) + ((size_t)n * SEQ + (tid >> 3)) * D + h * 128 + dq * 32 + (tid & 7) * 4;
    LAS float* OT = (LAS float*)(ST + 32 * 136);
    f32x4 S0 = {0.f, 0.f, 0.f, 0.f}, S1 = {0.f, 0.f, 0.f, 0.f};
    for (int q = tid; q < 32 * 136 / 2; q += NT) ((LAS unsigned*)ST)[q] = 0u;
    ScanRegs R0;
#define SC_LOAD(R, cc) do { const int cq_ = (cc) < 128 ? (cc) : 127; const size_t sb = (size_t)(sid0 + cq_); \
        _Pragma("unroll") for (int i2 = 0; i2 < 2; ++i2) { const int q = tid + 512 * i2; \
            R.rw[i2] = *(const v4u*)(Wb + sb * 8192 + (q >> 4) * 128 + (q & 15) * 8); R.rq[i2] = *(const v4u*)(QD + sb * 8192 + (q >> 4) * 128 + (q & 15) * 8); \
            R.rk[i2] = *(const v4u*)(KDT + sb * 8192 + (q >> 3) * 64 + (q & 7) * 8); } \
        R.ra = *(const v4u*)(ATT + sb * 4096 + (tid >> 3) * 64 + (tid & 7) * 8); \
        R.ru = *(const f32x4*)(U + sb * 8192 + (size_t)((dq * 8 + w) * 64 + lane) * 4); R.rdl = DL[sb]; } while (0)
#define SC_STORE(R) do { _Pragma("unroll") for (int i2 = 0; i2 < 2; ++i2) { const int q = tid + 512 * i2; \
            *(LAS v4u*)(Wt + (q >> 4) * 136 + (q & 15) * 8) = R.rw[i2]; *(LAS v4u*)(QDt + (q >> 4) * 136 + (q & 15) * 8) = R.rq[i2]; \
            *(LAS v4u*)(KDTt + (q >> 3) * 72 + (q & 7) * 8) = R.rk[i2]; } \
        *(LAS v4u*)(At + (tid >> 3) * 72 + (tid & 7) * 8) = R.ra; ucur = R.ru; dl = R.rdl; } while (0)
    f32x4 ucur; float dl;
    SC_LOAD(R0, 0);
    SC_STORE(R0);
    LDSBAR();
#define SC_STEP(cc, RL, RS, DRAIN, PH) do { \
        if (DRY < 2) SC_LOAD(RL, (cc) + 1); \
        f32x4 acc = {0.f, 0.f, 0.f, 0.f}, ao = {0.f, 0.f, 0.f, 0.f}; \
        bf16x8 sf_[4], wf_[4], qf_[4]; \
        _Pragma("unroll") for (int ks = 0; ks < 4; ++ks) { sf_[ks] = *(const LAS bf16x8*)(ST + (16 * nt + fr) * 136 + ks * 32 + fq * 8); wf_[ks] = *(const LAS bf16x8*)(Wt + (16 * mt + fr) * 136 + ks * 32 + fq * 8); } \
        _Pragma("unroll") for (int ks = 0; ks < 4; ++ks) qf_[ks] = *(const LAS bf16x8*)(QDt + (16 * mt + fr) * 136 + ks * 32 + fq * 8); \
        __builtin_amdgcn_sched_barrier(0);     \
        _Pragma("unroll") for (int ks = 0; ks < 4; ++ks) acc = MFMA16(wf_[ks], sf_[ks], acc); \
        _Pragma("unroll") for (int ks = 0; ks < 4; ++ks) ao = MFMA16(qf_[ks], sf_[ks], ao); \
        const f32x4 vn = ucur - acc; \
        { v2u o; o.x = pk2(vn[0], vn[1]); o.y = pk2(vn[2], vn[3]); *(LAS v2u*)(VNT + (16 * nt + fr) * 72 + 16 * mt + 4 * fq) = o; } \
        LDSBAR(); \
        S0 *= dl; S1 *= dl; \
        bf16x8 b0_[2], b1_[2], af_[2], kf_[2]; \
        _Pragma("unroll") for (int ks = 0; ks < 2; ++ks) { b0_[ks] = *(const LAS bf16x8*)(VNT + fr * 72 + ks * 32 + fq * 8); b1_[ks] = *(const LAS bf16x8*)(VNT + (16 + fr) * 72 + ks * 32 + fq * 8); \
            af_[ks] = *(const LAS bf16x8*)(At + (16 * mt + fr) * 72 + ks * 32 + fq * 8); kf_[ks] = *(const LAS bf16x8*)(KDTt + (16 * w + fr) * 72 + ks * 32 + fq * 8); } \
        __builtin_amdgcn_sched_barrier(0); \
        _Pragma("unroll") for (int ks = 0; ks < 2; ++ks) { S0 = MFMA16(kf_[ks], b0_[ks], S0); S1 = MFMA16(kf_[ks], b1_[ks], S1); ao = MFMA16(af_[ks], nt ? b1_[ks] : b0_[ks], ao); } \
        if (DRAIN) __builtin_amdgcn_s_waitcnt(0x0F70); \
        _Pragma("unroll") for (int e = 0; e < 4; ++e) OT[(PH) * 2304 + (16 * mt + 4 * fq + e) * 36 + 16 * nt + fr] = ao[e];     \
        LDSBAR(); \
        if (DRY == 0 && (PH) == 3) { _Pragma("unroll") for (int q_ = 0; q_ < 4; ++q_) *(f32x4*)(O + (size_t)((cc) - 3 + q_) * 64 * D) = *(const LAS f32x4*)(OT + q_ * 2304 + (tid >> 3) * 36 + (tid & 7) * 4); }     \
        { v2u o; o.x = pk2(S0[0], S0[1]); o.y = pk2(S0[2], S0[3]); *(LAS v2u*)(ST + fr * 136 + 16 * w + 4 * fq) = o; \
          o.x = pk2(S1[0], S1[1]); o.y = pk2(S1[2], S1[3]); *(LAS v2u*)(ST + (16 + fr) * 136 + 16 * w + 4 * fq) = o; } \
        if (DRY < 2) SC_STORE(RS); \
        LDSBAR(); } while (0)
#pragma unroll 1
    for (int c = 0; c < 128; c += 4) { SC_STEP(c, R0, R0, false, 0); SC_STEP(c + 1, R0, R0, false, 1); SC_STEP(c + 2, R0, R0, false, 2); SC_STEP(c + 3, R0, R0, false, 3); }
#undef SC_LOAD
#undef SC_STORE
#undef SC_STEP
    float* prec = lnd(p.out) + O_PREC + ((size_t)((l * 2 + n) * 8 + h)) * 16384;
    if (DRY == 0)
#pragma unroll
    for (int e = 0; e < 4; ++e) { prec[(size_t)(16 * w + 4 * fq + e) * 128 + dq * 32 + fr] = S0[e]; prec[(size_t)(16 * w + 4 * fq + e) * 128 + dq * 32 + 16 + fr] = S1[e]; }
    if (DRY) asm volatile("" :: "v"(S0), "v"(S1));
    LDSBAR();
}

__device__ __forceinline__ void gdn_decode(const CPar& p, int l, int it, LAS unsigned char* lds, int tid_) {
    const int tid = lnd_v(tid_);
    const int n = it >> 3, h = it & 7; const size_t m = (size_t)MPR + n;
    LAS float* qkv = (LAS float*)lds;
    LAS float* sc = qkv + 384;
    LAS float* PK = sc + 8;
    LAS float* PQ = PK + 2048;
    LAS float* VN = PQ + 2048;
    unsigned char* ws = lnd(p.ws);
    const bf16* qkvz = (const bf16*)(ws + WS_BIG); const float* BA = (const float*)(ws + WS_BA);
    const int w = tid >> 6, lane = tid & 63;
    if (tid < 384) {
        const int part = tid >> 7, d = tid & 127, col = part * 1024 + h * 128 + d;
        const float* cs = lnd(p.in[3]) + ((size_t)(l * NS + n) * 3) * 3072 + col; const float* cw = lnd(p.in[10]) + (size_t)l * 4 * 3072 + col;
        const float s0 = cs[0], s1 = cs[3072], s2 = cs[2 * 3072], xn = bf2f(qkvz[m * 4096 + col]);
        const float cv = cw[0] * s0 + cw[3072] * s1 + cw[2 * 3072] * s2 + cw[3 * 3072] * xn;
        qkv[tid] = silu_f(cv);
        float* so = lnd(p.out) + O_SCONV + ((size_t)(l * NS + n) * 3) * 3072 + col; so[0] = s1; so[3072] = s2; so[2 * 3072] = xn;
    }
    __syncthreads();
    if (w < 3) {
        const float a0 = (w == 1) ? qkv[128 + lane] : qkv[lane], a1 = (w == 1) ? qkv[192 + lane] : qkv[64 + lane];
        const float b0 = (w == 0) ? a0 : qkv[128 + lane], b1 = (w == 0) ? a1 : qkv[192 + lane];
        const float s = wave_sum(a0 * b0 + a1 * b1, lane);
        if (lane == 0) sc[w] = s;
    } else if (w == 3 && lane == 0) {
        const float braw = BA[m * 16 + h], araw = BA[m * 16 + 8 + h];
        const float xx = araw + lnd(p.in[12])[l * 8 + h]; const float sp = xx > 20.f ? xx : log1pf(expf(xx));
        sc[3] = 1.f / (1.f + expf(-braw)); sc[4] = expf(-expf(lnd(p.in[11])[l * 8 + h]) * sp);
    }
    __syncthreads();
    const float rq = rsqrtf(sc[0] + EPS) * 0.08838834764831845f, rk = rsqrtf(sc[1] + EPS), qk = sc[2] * rq * rk, beta = sc[3], eg = sc[4];
    const int dv4 = (tid & 31) * 4, grp = tid >> 5;
    const float* Sin = lnd(p.in[2]) + ((size_t)(l * NS + n) * 8 + h) * 16384;
    f32x4 S[8]; f32x4 pk = {0.f, 0.f, 0.f, 0.f}, pq = {0.f, 0.f, 0.f, 0.f};
#pragma unroll
    for (int i = 0; i < 8; ++i) { const int dk = grp * 8 + i; S[i] = __builtin_nontemporal_load((const f32x4*)(Sin + (size_t)dk * 128 + dv4)); pk += S[i] * (qkv[128 + dk] * rk); pq += S[i] * (qkv[dk] * rq); }
    *(LAS f32x4*)(PK + grp * 128 + dv4) = pk; *(LAS f32x4*)(PQ + grp * 128 + dv4) = pq;
    __syncthreads();
    if (tid < 128) {
        float ks = 0.f, qs = 0.f;
#pragma unroll
        for (int g = 0; g < 16; ++g) { ks += PK[g * 128 + tid]; qs += PQ[g * 128 + tid]; }
        const float vnew = beta * (qkv[256 + tid] - eg * ks);
        VN[tid] = vnew;
        ((float*)(ws + WS_O))[m * D + h * 128 + tid] = eg * qs + qk * vnew;
    }
    __syncthreads();
    float* So = lnd(p.out) + O_SREC + ((size_t)(l * NS + n) * 8 + h) * 16384;
    const f32x4 vn4 = *(const LAS f32x4*)(VN + dv4);
#pragma unroll
    for (int i = 0; i < 8; ++i) { const int dk = grp * 8 + i; __builtin_nontemporal_store(S[i] * eg + vn4 * (qkv[128 + dk] * rk), (f32x4*)(So + (size_t)dk * 128 + dv4)); }
    __syncthreads();
}

__device__ __forceinline__ void gdn_gate_rows(const CPar& p, int l, int gw, int NGW, int lane) {
    unsigned char* ws = lnd(p.ws);
    const float* O = (const float*)(ws + WS_O); const bf16* qkvz = (const bf16*)(ws + WS_BIG); bf16* OG = (bf16*)(ws + WS_OG);
    const float* gn = lnd(p.in[13]) + l * 128 + (lane & 7) * 16;
    f32x4 g4[4];
#pragma unroll
    for (int j = 0; j < 4; ++j) g4[j] = *(const f32x4*)(gn + 4 * j);
    f32x4 v[4]; v4u z0, z1;
    { const int mc = gw < MV ? gw : MV - 1; const f32x4* op = (const f32x4*)(O + (size_t)mc * D + lane * 16);
#pragma unroll
      for (int j = 0; j < 4; ++j) v[j] = op[j];
      const v4u* zp = (const v4u*)(qkvz + (size_t)mc * 4096 + 3072 + lane * 16); z0 = zp[0]; z1 = zp[1]; }
    for (int m = gw; m < MV; m += NGW) {
        f32x4 vn[4]; v4u zn0, zn1;
        { const int mc = (m + NGW < MV) ? m + NGW : MV - 1; const f32x4* op = (const f32x4*)(O + (size_t)mc * D + lane * 16);
#pragma unroll
          for (int j = 0; j < 4; ++j) vn[j] = op[j];
          const v4u* zp = (const v4u*)(qkvz + (size_t)mc * 4096 + 3072 + lane * 16); zn0 = zp[0]; zn1 = zp[1]; }
        float ss = 0.f;
#pragma unroll
        for (int j = 0; j < 4; ++j) ss += (v[j].x * v[j].x + v[j].y * v[j].y) + (v[j].z * v[j].z + v[j].w * v[j].w);
        ss += shx<1>(ss, lane); ss += shx<2>(ss, lane); ss += shx<4>(ss, lane);
        const float rstd = rsqrtf(ss * (1.f / 128.f) + EPS);
        const unsigned zz[8] = {z0.x, z0.y, z0.z, z0.w, z1.x, z1.y, z1.z, z1.w};
        unsigned ow[8];
#pragma unroll
        for (int j = 0; j < 4; ++j) {
            const float a0 = v[j].x * rstd * g4[j].x * silu_f(bflo(zz[2 * j])), a1 = v[j].y * rstd * g4[j].y * silu_f(bfhi(zz[2 * j]));
            const float a2 = v[j].z * rstd * g4[j].z * silu_f(bflo(zz[2 * j + 1])), a3 = v[j].w * rstd * g4[j].w * silu_f(bfhi(zz[2 * j + 1]));
            ow[2 * j] = pk2(a0, a1); ow[2 * j + 1] = pk2(a2, a3);
        }
        v4u* og = (v4u*)(OG + (size_t)m * D + lane * 16);
        og[0] = (v4u){ow[0], ow[1], ow[2], ow[3]}; og[1] = (v4u){ow[4], ow[5], ow[6], ow[7]};
#pragma unroll
        for (int j = 0; j < 4; ++j) v[j] = vn[j];
        z0 = zn0; z1 = zn1;
    }
    for (int e = gw * 64 + lane; e < 2 * 3 * 3072; e += NGW * 64) { const int n = e / 9216, r = e % 9216, j = r / 3072, col = r % 3072;
        lnd(p.out)[O_PCONV + (size_t)l * 18432 + e] = bf2f(qkvz[((size_t)n * SEQ + 8189 + j) * 4096 + col]); }
}

__device__ __forceinline__ void attn_prompt_item(const CPar& p, int item, LAS unsigned char* lds, int tid_) {
    const int tid = lnd_v(tid_);
    const int b = item >> 9, n = (item >> 8) & 1, g = (item >> 7) & 1, tile = item & 127;
    const int sh = 2 * b, seg = SEQ >> sh, P0 = tile * 64, segstart = P0 & ~(seg - 1), kp0 = P0 - 128;
    unsigned char* ws = lnd(p.ws);
    const bf16* Qb = (const bf16*)(ws + WS_QB); const bf16* Kb = (const bf16*)(ws + WS_KB); const bf16* Vb = (const bf16*)(ws + WS_VB);
    bf16* OB = (bf16*)(ws + WS_OB); float* LSE = (float*)(ws + WS_LSE);
    LAS bf16* Kt = (LAS bf16*)lds; LAS bf16* VTt = Kt + 192 * 72;
    const size_t kvbase = (size_t)((b * 2 + n) * 2 + g) * SEQ;
    bf16x8 bqa[2][2];
    { const int w_ = tid >> 6, l_ = tid & 63;
#pragma unroll
      for (int qt = 0; qt < 2; ++qt)
#pragma unroll
        for (int ks = 0; ks < 2; ++ks) bqa[qt][ks] = *(const bf16x8*)(Qb + ((size_t)((b * 2 + n) * 8 + g * 4 + (w_ >> 1)) * SEQ + P0 + (w_ & 1) * 32 + qt * 16 + (l_ & 15)) * 64 + ks * 32 + (l_ >> 4) * 8); }
#pragma unroll
    for (int i2 = 0; i2 < 3; ++i2) { const int q = tid + 512 * i2, row = q >> 3, c8 = (q & 7) * 8, pr = kp0 + row;
        v4u kx = {0u, 0u, 0u, 0u}, vx = {0u, 0u, 0u, 0u};
        if (pr >= segstart) { kx = *(const v4u*)(Kb + (kvbase + pr) * 64 + c8); vx = *(const v4u*)(Vb + (kvbase + pr) * 64 + c8); }
        *(LAS v4u*)(Kt + row * 72 + c8) = kx;
        VTt[(c8 + 0) * 200 + row] = (bf16)(vx.x & 0xffffu); VTt[(c8 + 1) * 200 + row] = (bf16)(vx.x >> 16);
        VTt[(c8 + 2) * 200 + row] = (bf16)(vx.y & 0xffffu); VTt[(c8 + 3) * 200 + row] = (bf16)(vx.y >> 16);
        VTt[(c8 + 4) * 200 + row] = (bf16)(vx.z & 0xffffu); VTt[(c8 + 5) * 200 + row] = (bf16)(vx.z >> 16);
        VTt[(c8 + 6) * 200 + row] = (bf16)(vx.w & 0xffffu); VTt[(c8 + 7) * 200 + row] = (bf16)(vx.w >> 16); }
    LDSBAR();
    const int w = tid >> 6, lane = tid & 63, fr = lane & 15, fq = lane >> 4;
    const int head = g * 4 + (w >> 1), qrow0 = (w & 1) * 32, kt0 = 2 * (w & 1);
    const float slope = exp2f(-(float)(head + 1)) * (float)(1 << sh);
#pragma unroll 1
    for (int qt = 0; qt < 2; ++qt) {
        bf16x8 bq[2];
        bq[0] = qt ? bqa[1][0] : bqa[0][0]; bq[1] = qt ? bqa[1][1] : bqa[0][1];
        const int fr2 = lnd_v(fr);
        f32x4 sc[10];
        const int qrel = qrow0 + qt * 16 + fr;
        const float c1 = 0.125f * 1.4426950408889634f, slope2 = slope * 1.4426950408889634f, tl = -slope2 * (float)(fr - 4 * fq);
        const bool fastseg = (kp0 >= segstart);
        float mx = -1e30f;
#pragma unroll
        for (int kt = 0; kt < 10; ++kt) {
            const int kk = kt - qt;
            if (kk < 0 || kk > 8) { sc[kt] = (f32x4){-1e30f, -1e30f, -1e30f, -1e30f}; }
            else {
                const bf16x8 a0 = *(const LAS bf16x8*)(Kt + ((kt0 + kt) * 16 + fr2) * 72 + fq * 8), a1 = *(const LAS bf16x8*)(Kt + ((kt0 + kt) * 16 + fr2) * 72 + 32 + fq * 8);
                f32x4 z = {0.f, 0.f, 0.f, 0.f}; z = MFMA16(a0, bq[0], z); z = MFMA16(a1, bq[1], z);
                if (fastseg && kk >= 1 && kk <= 7) {
                    const float cb = tl - slope2 * (float)(16 * (8 - kk));
#pragma unroll
                    for (int e = 0; e < 4; ++e) { const float sv = fmaf(z[e], c1, cb + slope2 * (float)e); z[e] = sv; mx = fmaxf(mx, sv); }
                } else {
#pragma unroll
                    for (int e = 0; e < 4; ++e) { const int keyrel = (kt0 + kt) * 16 + 4 * fq + e, dp = qrel + 128 - keyrel;
                        const bool valid = (dp >= 0) && (dp <= 128) && (kp0 + keyrel >= segstart);
                        const float sv = valid ? z[e] * c1 - slope2 * (float)dp : -1e30f; z[e] = sv; mx = fmaxf(mx, sv); }
                }
                sc[kt] = z;
            }
        }
        mx = fmaxf(mx, shx<16>(mx, lane)); mx = fmaxf(mx, shx<32>(mx, lane));
        float sm = 0.f;
#pragma unroll
        for (int kt = 0; kt < 10; ++kt)
#pragma unroll
            for (int e = 0; e < 4; ++e) { const float pe = __builtin_amdgcn_exp2f(sc[kt][e] - mx); sc[kt][e] = pe; sm += pe; }
        sm += shx<16>(sm, lane); sm += shx<32>(sm, lane);
        f32x4 oa[4];
#pragma unroll
        for (int dt = 0; dt < 4; ++dt) oa[dt] = (f32x4){0.f, 0.f, 0.f, 0.f};
#pragma unroll
        for (int s5 = 0; s5 < 5; ++s5) {
            const f32x4 plo = sc[2 * s5], phi = sc[2 * s5 + 1];
            v4u pw; pw.x = pk2(plo[0], plo[1]); pw.y = pk2(plo[2], plo[3]); pw.z = pk2(phi[0], phi[1]); pw.w = pk2(phi[2], phi[3]);
            const bf16x8 bp = __builtin_bit_cast(bf16x8, pw);
            const int kb = (kt0 + 2 * s5) * 16 + 4 * fq;
#pragma unroll
            for (int dt = 0; dt < 4; ++dt) { const v2u vlo = *(const LAS v2u*)(VTt + (dt * 16 + fr) * 200 + kb), vhi = *(const LAS v2u*)(VTt + (dt * 16 + fr) * 200 + kb + 16);
                const v4u vw = {vlo.x, vlo.y, vhi.x, vhi.y}; const bf16x8 av = __builtin_bit_cast(bf16x8, vw);
                oa[dt] = MFMA16(av, bp, oa[dt]); }
        }
        {
            const int pq = P0 + qrel, pl = pq & (seg - 1), res = pq >> (13 - sh), tok = (pl << sh) + res;
            const size_t m = (size_t)n * SEQ + tok; const float inv = 1.f / sm;
            bf16* op = OB + ((size_t)b * MV + m) * 512 + head * 64 + 4 * fq;
#pragma unroll
            for (int dt = 0; dt < 4; ++dt) { const f32x4 v = oa[dt] * inv; v2u o; o.x = pk2(v[0], v[1]); o.y = pk2(v[2], v[3]); *(v2u*)(op + dt * 16) = o; }
            if (fq == 0) LSE[((size_t)b * MV + m) * 8 + head] = mx * 0.6931471805599453f + __logf(sm);
        }
    }
    LDSBAR();
}
__device__ __forceinline__ void attn_decode_item(const CPar& p, int item, LAS unsigned char* lds, int tid_) {
    const int tid = lnd_v(tid_);
    const int n = item / 3, b = item % 3, sh = 2 * b, Wb = 128 << sh, dd = 1 << sh;
    unsigned char* ws = lnd(p.ws);
    const float* cache = lnd(p.in[4 + b]); const size_t os = (b == 0) ? O_SKV0 : (b == 1 ? O_SKV1 : O_SKV2);
    const float* newrow = lnd(p.out) + os + ((size_t)n * Wb + (Wb - 1)) * 256;
    LAS float* qf = (LAS float*)lds;
    LAS float* SC = qf + 512;
    LAS float* LS = SC + 8 * 132;
    { const bf16* Qs = (const bf16*)(ws + WS_QS) + (size_t)n * NQ + b * 512; qf[tid] = bf2f(Qs[tid]) * 0.125f; }
    __syncthreads();
#pragma unroll 1
    for (int pid = tid; pid < 129 * 8; pid += NT) { const int j = pid >> 3, hd = pid & 7, g = hd >> 2;
        const float* kp = (j == 0) ? newrow + g * 64 : cache + ((size_t)n * Wb + (Wb - j * dd)) * 256 + g * 64;
        float dot = 0.f;
#pragma unroll
        for (int q = 0; q < 16; ++q) { const f32x4 kv = *(const f32x4*)(kp + 4 * q); const f32x4 qv = *(const LAS f32x4*)(qf + hd * 64 + 4 * q); dot += (kv.x * qv.x + kv.y * qv.y) + (kv.z * qv.z + kv.w * qv.w); }
        SC[hd * 132 + j] = dot - exp2f(-(float)(hd + 1)) * (float)(j * dd); }
    __syncthreads();
    { const int hd = tid >> 6, lane = tid & 63;
      const float s0 = SC[hd * 132 + lane], s1 = SC[hd * 132 + 64 + lane], s2 = (lane == 0) ? SC[hd * 132 + 128] : -1e30f;
      float mx = fmaxf(fmaxf(s0, s1), s2);
      mx = wave_max(mx, lane);
      const float e0 = __expf(s0 - mx), e1 = __expf(s1 - mx), e2 = (lane == 0) ? __expf(s2 - mx) : 0.f;
      const float sum = wave_sum(e0 + e1 + e2, lane), inv = 1.f / sum;
      SC[hd * 132 + lane] = e0 * inv; SC[hd * 132 + 64 + lane] = e1 * inv; if (lane == 0) { SC[hd * 132 + 128] = e2 * inv; LS[hd] = mx + __logf(sum); } }
    __syncthreads();
    { const int hd = tid >> 6, dim = tid & 63, g = hd >> 2;
      float acc = SC[hd * 132] * newrow[128 + g * 64 + dim];
#pragma unroll 32
      for (int j = 1; j <= 128; ++j) acc += SC[hd * 132 + j] * cache[((size_t)n * Wb + (Wb - j * dd)) * 256 + 128 + g * 64 + dim];
      const size_t m = (size_t)MPR + n;
      ((bf16*)(ws + WS_OB))[((size_t)b * MV + m) * 512 + hd * 64 + dim] = (bf16)f2bf(acc);
      if (dim == 0) ((float*)(ws + WS_LSE))[((size_t)b * MV + m) * 8 + hd] = LS[hd]; }
    __syncthreads();
}
__device__ __forceinline__ void attn_merge_rows(const CPar& p, int gw, int NGW, int lane) {
    unsigned char* ws = lnd(p.ws);
    const bf16* OB = (const bf16*)(ws + WS_OB); const float* LSE = (const float*)(ws + WS_LSE); bf16* ATT = (bf16*)(ws + WS_ATT);
    const int head = lane >> 3;
    float l0, l1, l2; v4u a, bb, cc;
    { const int mc = gw < MV ? gw : MV - 1;
      l0 = LSE[((size_t)0 * MV + mc) * 8 + head]; l1 = LSE[((size_t)1 * MV + mc) * 8 + head]; l2 = LSE[((size_t)2 * MV + mc) * 8 + head];
      a = *(const v4u*)(OB + ((size_t)0 * MV + mc) * 512 + lane * 8); bb = *(const v4u*)(OB + ((size_t)1 * MV + mc) * 512 + lane * 8); cc = *(const v4u*)(OB + ((size_t)2 * MV + mc) * 512 + lane * 8); }
    for (int m = gw; m < MV; m += NGW) {
        const int mc = (m + NGW < MV) ? m + NGW : MV - 1;
        const float n0 = LSE[((size_t)0 * MV + mc) * 8 + head], n1 = LSE[((size_t)1 * MV + mc) * 8 + head], n2 = LSE[((size_t)2 * MV + mc) * 8 + head];
        const v4u na = *(const v4u*)(OB + ((size_t)0 * MV + mc) * 512 + lane * 8), nb = *(const v4u*)(OB + ((size_t)1 * MV + mc) * 512 + lane * 8), nc = *(const v4u*)(OB + ((size_t)2 * MV + mc) * 512 + lane * 8);
        const float mx = fmaxf(l0, fmaxf(l1, l2)); float w0 = __expf(l0 - mx), w1 = __expf(l1 - mx), w2 = __expf(l2 - mx); const float inv = 1.f / (w0 + w1 + w2);
        w0 *= inv; w1 *= inv; w2 *= inv;
        v4u o;
        o.x = pk2(w0 * bflo(a.x) + w1 * bflo(bb.x) + w2 * bflo(cc.x), w0 * bfhi(a.x) + w1 * bfhi(bb.x) + w2 * bfhi(cc.x));
        o.y = pk2(w0 * bflo(a.y) + w1 * bflo(bb.y) + w2 * bflo(cc.y), w0 * bfhi(a.y) + w1 * bfhi(bb.y) + w2 * bfhi(cc.y));
        o.z = pk2(w0 * bflo(a.z) + w1 * bflo(bb.z) + w2 * bflo(cc.z), w0 * bfhi(a.z) + w1 * bfhi(bb.z) + w2 * bfhi(cc.z));
        o.w = pk2(w0 * bflo(a.w) + w1 * bflo(bb.w) + w2 * bflo(cc.w), w0 * bfhi(a.w) + w1 * bfhi(bb.w) + w2 * bfhi(cc.w));
        *(v4u*)(ATT + (size_t)m * 512 + lane * 8) = o;
        l0 = n0; l1 = n1; l2 = n2; a = na; bb = nb; cc = nc;
    }
}
__device__ __forceinline__ void kv_shift_copy(const CPar& p, int wid, int nwk, int tid, int first) {
    for (int pc = wid; pc < NS * 21; pc += nwk) {
        if (first != 2 && ((pc % 5 < 2) != (first == 1))) continue;
        const int n = pc / 21, r = pc % 21, b = (r == 0) ? 0 : (r < 5 ? 1 : 2), piece = (b == 0) ? 0 : (b == 1 ? r - 1 : r - 5);
        const int Wb = 128 << (2 * b), row0 = piece * 128, nrow = (row0 + 128 <= Wb - 1) ? 128 : (Wb - 1 - row0);
        const size_t os = (b == 0) ? O_SKV0 : (b == 1 ? O_SKV1 : O_SKV2);
        const f32x4* src = (const f32x4*)lnd(p.in[4 + b]) + ((size_t)n * Wb + row0 + 1) * 64; f32x4* dst = (f32x4*)(lnd(p.out) + os) + ((size_t)n * Wb + row0) * 64;
        for (int f = tid; f < nrow * 64; f += NT) __builtin_nontemporal_store(__builtin_nontemporal_load(src + f), dst + f);
    }
}

#define XB_TMO      128
#define XB_XCNT(j)  (256  + 64 * (j))
#define XB_XSUB(j)  (1280 + 64 * (j))
#define XB_XGEN(j)  (2304 + 64 * (j))
#define XB_TOP      3328
#define XB_TOPGEN   3392
#define XCD_BAR_WORDS 3456
#define XB_SPIN_CAP (1u << 18)

__device__ __forceinline__ unsigned xb_ld(unsigned* p)              { return __hip_atomic_load(p, __ATOMIC_RELAXED, __HIP_MEMORY_SCOPE_AGENT); }
__device__ __forceinline__ unsigned xb_add(unsigned* p, unsigned v) { return __hip_atomic_fetch_add(p, v, __ATOMIC_RELAXED, __HIP_MEMORY_SCOPE_AGENT); }
__device__ __forceinline__ unsigned xb_xcc_id() { return (unsigned)__builtin_amdgcn_s_getreg((3 << 11) | 20) & 0xFu; }
#define XB_SPIN(cond, bar) do { unsigned _sp = 0; while (cond) { __builtin_amdgcn_s_sleep(1); \
    if ((++_sp & 255u) == 0u) { if (xb_ld(&(bar)[XB_TMO])) break; if (_sp > XB_SPIN_CAP) { atomicAdd(&(bar)[XB_TMO], 1u); break; } } } } while (0)

struct XcdBarrier {
    unsigned* bar; unsigned x;
    volatile LAS unsigned* st;
};

__device__ __forceinline__ XcdBarrier xcd_barrier_post(unsigned* bar, volatile LAS unsigned* st) {
    XcdBarrier b; b.bar = bar; b.x = xb_xcc_id(); b.st = st;
    if (threadIdx.x == 0) (void)xb_add(&bar[XB_XCNT(b.x)], 1u);
    return b;
}
__device__ __forceinline__ void xcd_barrier_complete(unsigned* bar, unsigned x, unsigned& nloc, unsigned& nx) {
    const unsigned G = gridDim.x * gridDim.y * gridDim.z;
    unsigned sum, cnt, mine, sp = 0u;
    for (;;) {
        sum = 0u; cnt = 0u; mine = 0u;
#pragma unroll
        for (unsigned j = 0; j < 16; ++j) { const unsigned c = xb_ld(&bar[XB_XCNT(j)]); sum += c; cnt += (c > 0u) ? 1u : 0u; mine = (j == x) ? c : mine; }
        if (sum == G) break;
        __builtin_amdgcn_s_sleep(1);
        if ((++sp & 255u) == 0u) { if (xb_ld(&bar[XB_TMO])) break; if (sp > XB_SPIN_CAP) { atomicAdd(&bar[XB_TMO], 1u); break; } }
    }
    nloc = mine > 0u ? mine : 1u; nx = cnt > 0u ? cnt : 1u;
}

__device__ __forceinline__ void xcd_barrier(const XcdBarrier& b) {
    asm volatile("s_waitcnt vmcnt(0)" ::: "memory");
    __syncthreads();
    if (threadIdx.x == 0) {
        unsigned* bar = b.bar;
        __builtin_amdgcn_s_waitcnt(0);
        unsigned nloc = b.st[0], nx = b.st[1];
        if (nloc == 0u) { xcd_barrier_complete(bar, b.x, nloc, nx); b.st[0] = nloc; b.st[1] = nx; }
        const unsigned old = xb_add(&bar[XB_XSUB(b.x)], 1u);
        const unsigned gen = old / nloc;
        if (old + 1u == (gen + 1u) * nloc) {
            __builtin_amdgcn_fence(__ATOMIC_RELEASE, "agent");
            asm volatile("s_waitcnt vmcnt(0)" ::: "memory");
            const unsigned og = xb_add(&bar[XB_TOP], 1u);
            const unsigned tg = og / nx;
            if (og + 1u == (tg + 1u) * nx) xb_add(&bar[XB_TOPGEN], 1u);
            else XB_SPIN(xb_ld(&bar[XB_TOPGEN]) == tg, bar);
            __builtin_amdgcn_fence(__ATOMIC_ACQUIRE, "agent");
            xb_add(&bar[XB_XGEN(b.x)], 1u);
            asm volatile("s_waitcnt vmcnt(0)" ::: "memory");
        } else {
            XB_SPIN(xb_ld(&bar[XB_XGEN(b.x)]) == gen, bar);
            __builtin_amdgcn_fence(__ATOMIC_ACQUIRE, "agent");
            asm volatile("s_waitcnt vmcnt(0)" ::: "memory");
        }
    }
    __syncthreads();
}

constexpr int N_PHASES = 28;
__global__ void __launch_bounds__(NT, 2) yoco_fwd(Par p_in) {
    extern __shared__ __attribute__((aligned(16))) unsigned char lds_raw[];
    LAS unsigned char* lds = (LAS unsigned char*)lds_raw;
    cg::grid_group grid = cg::this_grid();
    const int lo = p_in.ph_lo, hi = p_in.ph_hi;
    const int wave0 = __builtin_amdgcn_readfirstlane((int)threadIdx.x >> 6);
    if (blockIdx.x == 0) for (int q = threadIdx.x; q < XCD_BAR_WORDS; q += NT) __hip_atomic_store((unsigned*)p_in.ws + q, 0u, __ATOMIC_RELAXED, __HIP_MEMORY_SCOPE_AGENT);
    volatile LAS unsigned* bst = (volatile LAS unsigned*)(lds + LDS_BYTES - 16);
    if (threadIdx.x < 4) bst[threadIdx.x] = 0u;
    __syncthreads();
    XcdBarrier xbar; xbar.bar = (unsigned*)p_in.ws; xbar.x = 0; xbar.st = bst;
    int nbar = 0;
#pragma unroll 1
    for (int it_ = 2 * lo; it_ < 2 * hi; ++it_) {
        const int ph = it_ >> 1;
        const CPar* kp_ = (const CPar*)__builtin_amdgcn_kernarg_segment_ptr(); asm volatile("" : "+s"(kp_)); const CPar& p = *kp_;
        const int wave = lnd_s(wave0), tid = lnd_v((wave << 6) | (int)__builtin_amdgcn_mbcnt_hi(~0u, __builtin_amdgcn_mbcnt_lo(~0u, 0u))), lane = tid & 63;
        const int G = lnd_s((int)gridDim.x), bid = lnd_s((int)blockIdx.x), gw = bid * NW + wave, NGW = G * NW;
        unsigned char* ws = lnd(p.ws);
        float* X = (float*)(ws + WS_X); bf16* XN = (bf16*)(ws + WS_XN); bf16* BIG = (bf16*)(ws + WS_BIG); float* SSb = (float*)(ws + WS_SS);
        int l, k;
        if (ph == 0) { l = 0; k = 0; }
        else if (ph < 15) { l = (ph - 1) / 7; const int j = (ph - 1) % 7; k = (j < 5) ? 1 + j : 2 + j; }
        else if (ph < 27) { l = 2 + (ph - 15) / 6; const int j = (ph - 15) % 6; k = (j < 4) ? 10 + j : 11 + j; }
        else { l = 3; k = 17; }
#ifndef PROBE_DUP
#define PROBE_DUP 0
#endif
#ifndef PROBE_DUPPH
#define PROBE_DUPPH 0ull
#endif
#ifndef PROBE_SYNC
#define PROBE_SYNC 0
#endif
        if ((it_ & 1) && !((PROBE_DUP >> k) & 1) && !((PROBE_DUPPH >> ph) & 1)) continue;
        {
        if (k == 0) { p0_weights(p, lds, gw, NGW, wave, lane, 0, (G > 64) ? P0_NA : P0_NITEMS); p0_prologue(p, lds, gw, NGW, wave, lane); }
        else if (k == 1) {
            pg8::Gemm g{XN, (const bf16*)(ws + WS_WIN) + (size_t)l * NPROJ_PAD * D, MPR, 4096, D}; pg8::StaticOrder S; S.init(MPR, 4096, G, bid);
            EpiProj E{BIG, SSb + (size_t)(2 * l) * MPR};
            pg8::gemm_phase<EpiProj, pg8::StaticOrder, true, true>(lds, g, S, E, tid);
            mini_items(p, 0, l, k, bid, G, tid, lds);
        } else if (k == 2) {
#ifndef NO_PREP
            for (int pi = bid; pi < 1024; pi += G) gdn_prep_pair(p, l, pi, lds, tid);
#endif
        } else if (k == 3) {
#ifndef NO_SCAN
            const int nscan = (G > 64) ? 64 : 0;
#ifndef PROBE_DRY
#define PROBE_DRY 0
#endif
            if (bid < nscan) { const int sit = (((bid & 7) * 2 + (bid >> 5)) << 2) | ((bid >> 3) & 3); if (PROBE_DRY) gdn_scan<PROBE_DRY>(p, l, sit, lds, tid); gdn_scan<0>(p, l, sit, lds, tid); }
            else {
                const int wid = bid - nscan, nwk = G - nscan;
                if (nscan == 0) for (int it = bid; it < 64; it += G) gdn_scan<0>(p, l, it, lds, tid);
                for (int it = wid; it < NS * 8; it += nwk) gdn_decode(p, l, it, lds, tid);
                if (l == 0 && nscan) { __syncthreads(); p0_weights(p, lds, wid * NW + wave, nwk * NW, wave, lane, P0_NA, P0_NITEMS); }
                kv_shift_copy(p, wid, nwk, tid, nscan ? (l == 0 ? 1 : 0) : 2);
            }
#endif
        } else if (k == 4) gdn_gate_rows(p, l, gw, NGW, lane);
        else if (k == 5 || k == 8 || k == 13 || k == 16) {
            const bf16* A; const bf16* Bt; int K;
            if (k == 5) { A = (const bf16*)(ws + WS_OG); Bt = (const bf16*)(ws + WS_WOUT) + (size_t)l * D * D; K = D; }
            else if (k == 13) { A = (const bf16*)(ws + WS_ATT); Bt = (const bf16*)(ws + WS_WO) + (size_t)(l - 2) * D * 512; K = 512; }
            else { A = BIG; Bt = (const bf16*)(ws + WS_WDN) + (size_t)l * D * FF; K = FF; }
            const int ssi = (k == 5 || k == 13) ? 2 * l + 1 : 2 * l + 2;
            pg8::Gemm g{A, Bt, MPR, D, K}; pg8::StaticOrder S; S.init(MPR, D, G, bid);
            EpiRes E{X, XN, SSb + (size_t)ssi * MPR, (k == 5 && l == 0) ? lnd(p.in[0]) : (const float*)X};
            pg8::gemm_phase<EpiRes, pg8::StaticOrder, true, true>(lds, g, S, E, tid);
            mini_items(p, 1, l, k, bid, G, tid, lds);
        } else if (k == 7 || k == 15) {
            pg8::Gemm g{XN, (const bf16*)(ws + WS_WUP) + (size_t)l * FF * D, MPR, FF, D}; pg8::StaticOrder S; S.init(MPR, FF, G, bid);
            EpiRelu2 E{BIG, FF, SSb + (size_t)(2 * l + 1) * MPR};
            pg8::gemm_phase<EpiRelu2, pg8::StaticOrder, true, true>(lds, g, S, E, tid);
            mini_items(p, 2, l, k, bid, G, tid, lds);
        } else if (k == 10) {
            const int Nn = (l == 2) ? NQKV2 : NQ;
            pg8::Gemm g{XN, (const bf16*)(ws + (l == 2 ? WS_WQKV2 : WS_WQ3)), MPR, Nn, D}; pg8::StaticOrder S; S.init(MPR, Nn, G, bid);
            EpiQKV E{(bf16*)(ws + WS_QB), (bf16*)(ws + WS_KB), (bf16*)(ws + WS_VB), lnd(p.out), SSb + (size_t)(2 * l) * MPR};
            pg8::gemm_phase<EpiQKV, pg8::StaticOrder, true, true>(lds, g, S, E, tid);
            mini_items(p, 3, l, k, bid, G, tid, lds);
        } else if (k == 11) {
#ifndef NO_ATTN
            for (int it = bid; it < 1536 + 384; it += G) { if (it < 1536) attn_prompt_item(p, it, lds, tid); else attn_decode_item(p, it - 1536, lds, tid); }
#endif
        } else if (k == 12) attn_merge_rows(p, gw, NGW, lane);
        else final_norm(X, lnd(p.in[21]), lnd(p.out), gw, NGW, lane);
        }
        if (it_ + 1 < 2 * hi) {
            if (nbar == 0) grid.sync();
            else xcd_barrier(xbar);
            if (nbar == 0) xbar = xcd_barrier_post((unsigned*)p_in.ws, bst);
            ++nbar;
            for (int e = 0; e < PROBE_SYNC; ++e) xcd_barrier(xbar);
        }
    }
}

extern "C" void kernel_launch(void* const* d_in, const int* in_sizes, int n_in, void* d_out, int out_size, void* d_ws, size_t ws_size, hipStream_t stream) {
    static int grid = 0;
    if (grid == 0) {
        if (n_in != 22 || (size_t)out_size != O_END || ws_size < WS_END) { fprintf(stderr, "kernel_launch: unexpected shapes (n_in %d, out %d, ws %zu)\n", n_in, out_size, ws_size); grid = -1; return; }
        int dev = 0, cus = 0, per_cu = 0;
        if (hipGetDevice(&dev) != hipSuccess || hipDeviceGetAttribute(&cus, hipDeviceAttributeMultiprocessorCount, dev) != hipSuccess) { grid = -1; return; }
        if (hipFuncSetAttribute((const void*)yoco_fwd, hipFuncAttributeMaxDynamicSharedMemorySize, LDS_BYTES) != hipSuccess) { fprintf(stderr, "kernel_launch: hipFuncSetAttribute failed\n"); grid = -1; return; }
        if (hipOccupancyMaxActiveBlocksPerMultiprocessor(&per_cu, (const void*)yoco_fwd, NT, LDS_BYTES) != hipSuccess || per_cu < 1) { fprintf(stderr, "kernel_launch: occupancy query says %d\n", per_cu); grid = -1; return; }
        grid = cus * per_cu;
    }
    if (grid < 0) return;
    Par a{};
    for (int i = 0; i < 22; ++i) a.in[i] = (const float*)d_in[i];
    a.out = (float*)d_out; a.ws = (unsigned char*)d_ws;
#if MK_MULTI
    for (int ph = 0; ph < N_PHASES; ++ph) { a.ph_lo = ph; a.ph_hi = ph + 1; hipLaunchKernelGGL(yoco_fwd, dim3(grid), dim3(NT), LDS_BYTES, stream, a); }
#else
    a.ph_lo = 0; a.ph_hi = N_PHASES;
    void* args[] = {&a};
    hipError_t e = hipLaunchCooperativeKernel((const void*)yoco_fwd, dim3(grid), dim3(NT), args, LDS_BYTES, stream);
    if (e != hipSuccess) fprintf(stderr, "kernel_launch: cooperative launch failed: %s (grid %d)\n", hipGetErrorString(e), grid);
#endif
}
```
